# Optimizing an MI355X kernel written in HIP

```python
import math
import jax
import jax.numpy as jnp
from jax import lax
import numpy as np

D_MODEL = 1024
BATCH = 8
SEQ = 4096
DEPTH = 2

N_META = 16
D_FF = 4 * D_MODEL
GDN_HEADS = 4
GDN_DK = 128
GDN_DV = 128
GDN_CONV = 4
GDN_CHUNK = 64
SB_HEADS = 8
SB_DH = 64
SB_BLOCK = 128
HG_HEADS = 8
HG_DK = D_MODEL // HG_HEADS
HG_DV = D_MODEL // HG_HEADS
HG_CHUNK = 64

N_EVEN = (DEPTH + 1) // 2
N_ODD = DEPTH // 2
DN_ALPHA = float((2 * DEPTH) ** 0.25)
DN_BETA = float((8 * DEPTH) ** -0.25)
LN_EPS = 1e-5
RMS_EPS = 1e-6
L2_EPS = 1e-6

GDN_QK_W = GDN_HEADS * GDN_DK
GDN_V_W = GDN_HEADS * GDN_DV
SB_W = SB_HEADS * SB_DH
AB_SPLITS = (GDN_QK_W, GDN_QK_W, GDN_V_W, GDN_V_W, GDN_HEADS, GDN_HEADS, SB_W, SB_W, SB_W)
AB_IN = sum(AB_SPLITS)
AB_OUT_IN = GDN_V_W + SB_W
HG_K_W = HG_HEADS * HG_DK
HG_V_W = HG_HEADS * HG_DV
C_SPLITS = (HG_K_W, HG_K_W, HG_V_W, HG_V_W)
C_IN = sum(C_SPLITS)

kernel_name = "hybrid_gdn_stickbreak_hgrn2_deepnorm"


def _split(a, sizes):
    idx = np.cumsum(sizes)[:-1].tolist()
    return jnp.split(a, idx, axis=-1)


def _front_pad(a, pad):
    return jnp.pad(a, [(0, 0), (pad, 0)] + [(0, 0)] * (a.ndim - 2))


def _to_chunks(a, n, c):
    bn, _, h, d = a.shape
    return jnp.transpose(a.reshape(bn, n, c, h, d), (1, 0, 3, 2, 4))


def _from_chunks(o):
    n, bn, h, c, d = o.shape
    return jnp.transpose(o, (1, 0, 3, 2, 4)).reshape(bn, n * c, h, d)


def layer_norm(x, g, b):
    xf = x.astype(jnp.float32)
    mu = jnp.mean(xf, axis=-1, keepdims=True)
    var = jnp.mean(jnp.square(xf - mu), axis=-1, keepdims=True)
    y = (xf - mu) * lax.rsqrt(var + LN_EPS)
    return (y * g.astype(jnp.float32) + b.astype(jnp.float32)).astype(x.dtype)


def rms_norm(x, g):
    xf = x.astype(jnp.float32)
    y = xf * lax.rsqrt(jnp.mean(xf * xf, axis=-1, keepdims=True) + RMS_EPS)
    return y * g.astype(jnp.float32)


def l2_normalize(x):
    xf = x.astype(jnp.float32)
    return xf * lax.rsqrt(jnp.sum(xf * xf, axis=-1, keepdims=True) + L2_EPS)


def causal_depthwise_conv(x, w):
    k_w, ch = w.shape
    return lax.conv_general_dilated(
        x, w[:, None, :].astype(x.dtype), window_strides=(1,), padding=[(k_w - 1, 0)],
        dimension_numbers=("NWC", "WIO", "NWC"), feature_group_count=ch)


def gated_delta_rule_chunked(q, k, v, g, beta):
    bn, t_len, h, dk = q.shape
    dv = v.shape[-1]
    c = GDN_CHUNK
    n = t_len // c
    q, k, v = (_to_chunks(a, n, c) for a in (q, k, v))
    g, beta = (_to_chunks(a[..., None], n, c)[..., 0] for a in (g, beta))
    gc = jnp.cumsum(g, axis=-1)
    causal = jnp.tril(jnp.ones((c, c), dtype=bool))
    strict = jnp.tril(jnp.ones((c, c), dtype=bool), -1)
    decay = jnp.exp(jnp.where(causal, gc[..., :, None] - gc[..., None, :], -jnp.inf))
    kb = k * beta[..., None]
    m = jnp.where(strict, jnp.einsum("nbhid,nbhjd->nbhij", kb, k) * decay, 0.0)
    eye = jnp.broadcast_to(jnp.eye(c, dtype=jnp.float32), m.shape)
    t_inv = lax.linalg.triangular_solve(eye + m, eye, left_side=True, lower=True, unit_diagonal=True)
    u = jnp.einsum("nbhij,nbhjd->nbhid", t_inv, v * beta[..., None])
    w = jnp.einsum("nbhij,nbhjd->nbhid", t_inv, kb * jnp.exp(gc)[..., None])
    a_intra = jnp.einsum("nbhid,nbhjd->nbhij", q, k) * decay
    q_dec = q * jnp.exp(gc)[..., None]
    k_dec = k * jnp.exp(gc[..., -1:] - gc)[..., None]
    g_tot = jnp.exp(gc[..., -1])

    def step(s, xs):
        u_n, w_n, qd_n, kd_n, a_n, gt_n = xs
        v_new = u_n - jnp.einsum("bhcd,bhde->bhce", w_n, s)
        o_n = jnp.einsum("bhcd,bhde->bhce", qd_n, s) + jnp.einsum("bhij,bhje->bhie", a_n, v_new)
        s = s * gt_n[..., None, None] + jnp.einsum("bhcd,bhce->bhde", kd_n, v_new)
        return s, o_n

    s0 = jnp.zeros((bn, h, dk, dv), jnp.float32)
    _, o = lax.scan(step, s0, (u, w, q_dec, k_dec, a_intra, g_tot))
    return _from_chunks(o)


def stick_breaking_attention(q, k, v):
    bn, l_len, h, d = q.shape
    pad = (-l_len) % SB_BLOCK
    t_len = l_len + pad
    nb = t_len // SB_BLOCK
    to_bhtd = lambda a: jnp.moveaxis(_front_pad(a.astype(jnp.float32), pad), 1, 2)
    q, k, v = (to_bhtd(a) for a in (q, k, v))
    q = q * (d ** -0.5)
    key_pos = jnp.arange(t_len)
    q_blocks = jnp.moveaxis(q.reshape(bn, h, nb, SB_BLOCK, d), 2, 0)
    q_pos = jnp.arange(t_len).reshape(nb, SB_BLOCK)

    def block(args):
        qb, qp = args
        z = jnp.einsum("bhqd,bhkd->bhqk", qb, k)
        allowed = (key_pos[None, :] < qp[:, None]) & (key_pos[None, :] >= pad)
        log_1m = jnp.where(allowed, jax.nn.log_sigmoid(-z), 0.0)
        after = lax.cumsum(log_1m, axis=3, reverse=True) - log_1m
        wgt = jnp.where(allowed, jnp.exp(jax.nn.log_sigmoid(z) + after), 0.0)
        return jnp.einsum("bhqk,bhkd->bhqd", wgt, v)

    o = lax.map(block, (q_blocks, q_pos))
    o = jnp.moveaxis(o, 0, 2).reshape(bn, h, t_len, d)[:, :, pad:]
    return jnp.moveaxis(o, 1, 2).reshape(bn, l_len, h * d)


def hgrn2_chunked(q, k, v, logf):
    bn, t_len, h, dk = q.shape
    dv = v.shape[-1]
    c = HG_CHUNK
    n = t_len // c
    q, k, v, logf = (_to_chunks(a, n, c) for a in (q, k, v, logf))
    b = jnp.cumsum(logf, axis=3)
    causal = jnp.tril(jnp.ones((c, c), dtype=bool))[:, :, None]

    def step(s, xs):
        q_n, k_n, v_n, b_n = xs
        pair = jnp.exp(jnp.where(causal, b_n[:, :, :, None, :] - b_n[:, :, None, :, :], -jnp.inf))
        a_n = jnp.einsum("bhtc,bhsc,bhtsc->bhts", q_n, k_n, pair)
        b_last = b_n[:, :, -1:, :]
        o_n = (jnp.einsum("bhtc,bhce->bhte", q_n * jnp.exp(b_n), s)
               + jnp.einsum("bhts,bhse->bhte", a_n, v_n))
        s = (jnp.exp(b_last)[:, :, 0, :, None] * s
             + jnp.einsum("bhsc,bhse->bhce", k_n * jnp.exp(b_last - b_n), v_n))
        return s, o_n

    s0 = jnp.zeros((bn, h, dk, dv), jnp.float32)
    _, o = lax.scan(step, s0, (q, k, v, b))
    return _from_chunks(o)


def mixer_gdn_sb(h, w_in, conv_w, a_log, dt_bias, gnorm_g, w_out):
    bn, l_len, _ = h.shape
    qa, ka, va, za, ba, aa, qb, kb, vb = _split(h @ w_in, AB_SPLITS)
    qkv = jax.nn.silu(causal_depthwise_conv(jnp.concatenate([qa, ka, va], axis=-1), conv_w))
    qa, ka, va = _split(qkv, (GDN_QK_W, GDN_QK_W, GDN_V_W))
    qa = l2_normalize(qa.reshape(bn, l_len, GDN_HEADS, GDN_DK)) * (GDN_DK ** -0.5)
    ka = l2_normalize(ka.reshape(bn, l_len, GDN_HEADS, GDN_DK))
    va = va.reshape(bn, l_len, GDN_HEADS, GDN_DV).astype(jnp.float32)
    beta = jax.nn.sigmoid(ba.astype(jnp.float32))
    g = -jnp.exp(a_log.astype(jnp.float32)) * jax.nn.softplus(aa.astype(jnp.float32) + dt_bias.astype(jnp.float32))
    pad = (-l_len) % GDN_CHUNK
    oa = gated_delta_rule_chunked(*(_front_pad(a, pad) for a in (qa, ka, va, g, beta)))[:, pad:]
    oa = rms_norm(oa, gnorm_g) * jax.nn.silu(za.reshape(bn, l_len, GDN_HEADS, GDN_DV).astype(jnp.float32))
    oa = oa.reshape(bn, l_len, GDN_V_W)
    shp = (bn, l_len, SB_HEADS, SB_DH)
    ob = stick_breaking_attention(qb.reshape(shp), kb.reshape(shp), vb.reshape(shp))
    return jnp.concatenate([oa.astype(h.dtype), ob.astype(h.dtype)], axis=-1) @ w_out


def mixer_hgrn2(h, w_in, lb, gnorm_g, w_out):
    bn, l_len, _ = h.shape
    q, f, i, z = _split(h @ w_in, C_SPLITS)
    shp_k = (bn, l_len, HG_HEADS, HG_DK)
    shp_v = (bn, l_len, HG_HEADS, HG_DV)
    lbf = lb.astype(jnp.float32).reshape(HG_HEADS, HG_DK)
    fgate = lbf + (1.0 - lbf) * jax.nn.sigmoid(f.astype(jnp.float32).reshape(shp_k))
    logf = jnp.log(fgate)
    k = 1.0 - fgate
    q = jax.nn.silu(q.astype(jnp.float32)).reshape(shp_k)
    v = i.astype(jnp.float32).reshape(shp_v)
    pad = (-l_len) % HG_CHUNK
    o = hgrn2_chunked(*(_front_pad(a, pad) for a in (q, k, v, logf)))[:, pad:]
    o = rms_norm(o, gnorm_g) * jax.nn.silu(z.astype(jnp.float32).reshape(shp_v))
    return o.reshape(bn, l_len, HG_V_W).astype(h.dtype) @ w_out


def squared_relu_mlp(h, w1, w2):
    return jnp.square(jax.nn.relu(h @ w1)) @ w2


def setup_inputs(seed: int = 0) -> dict:
    key = jax.random.key(seed)
    ks = jax.random.split(key, 18)
    nrm = lambda k, shape, scale: jax.random.normal(k, shape, jnp.float32) * scale
    x = nrm(ks[0], (BATCH, SEQ, D_MODEL), 1.0)
    meta_tokens = nrm(ks[1], (N_META, D_MODEL), 1.0)
    ab_w_in = nrm(ks[2], (N_EVEN, D_MODEL, AB_IN), D_MODEL ** -0.5)
    ab_conv_w = nrm(ks[3], (N_EVEN, GDN_CONV, 2 * GDN_QK_W + GDN_V_W), GDN_CONV ** -0.5)
    ab_a_log = jnp.log(jax.random.uniform(ks[4], (N_EVEN, GDN_HEADS), jnp.float32, 1.0, 16.0))
    dt = jnp.exp(jax.random.uniform(ks[5], (N_EVEN, GDN_HEADS), jnp.float32, math.log(1e-3), math.log(1e-1)))
    ab_dt_bias = dt + jnp.log(-jnp.expm1(-dt))
    ab_gnorm_g = 1.0 + nrm(ks[6], (N_EVEN, GDN_DV), 0.02)
    ab_w_out = nrm(ks[7], (N_EVEN, AB_OUT_IN, D_MODEL), (AB_OUT_IN ** -0.5) * DN_BETA)
    c_w_in = nrm(ks[8], (N_ODD, D_MODEL, C_IN), D_MODEL ** -0.5)
    c_lb_raw = nrm(ks[9], (DEPTH, HG_K_W), 0.1)
    c_gnorm_g = 1.0 + nrm(ks[10], (N_ODD, HG_DV), 0.02)
    c_w_out = nrm(ks[11], (N_ODD, HG_V_W, D_MODEL), (HG_V_W ** -0.5) * DN_BETA)
    ln_mix_g = 1.0 + nrm(ks[12], (DEPTH, D_MODEL), 0.02)
    ln_mix_b = nrm(ks[13], (DEPTH, D_MODEL), 0.02)
    mlp_w1 = nrm(ks[14], (DEPTH, D_MODEL, D_FF), D_MODEL ** -0.5)
    mlp_w2 = nrm(ks[15], (DEPTH, D_FF, D_MODEL), (D_FF ** -0.5) * DN_BETA)
    ln_ffn_g = 1.0 + nrm(ks[16], (DEPTH, D_MODEL), 0.02)
    ln_ffn_b = nrm(ks[17], (DEPTH, D_MODEL), 0.02)
    return {"x": x, "meta_tokens": meta_tokens, "ab_w_in": ab_w_in, "ab_conv_w": ab_conv_w,
            "ab_a_log": ab_a_log, "ab_dt_bias": ab_dt_bias, "ab_gnorm_g": ab_gnorm_g, "ab_w_out": ab_w_out,
            "c_w_in": c_w_in, "c_lb_raw": c_lb_raw, "c_gnorm_g": c_gnorm_g, "c_w_out": c_w_out,
            "ln_mix_g": ln_mix_g, "ln_mix_b": ln_mix_b, "mlp_w1": mlp_w1, "mlp_w2": mlp_w2,
            "ln_ffn_g": ln_ffn_g, "ln_ffn_b": ln_ffn_b}


def reference(x, meta_tokens, ab_w_in, ab_conv_w, ab_a_log, ab_dt_bias, ab_gnorm_g, ab_w_out,
              c_w_in, c_lb_raw, c_gnorm_g, c_w_out, ln_mix_g, ln_mix_b, mlp_w1, mlp_w2,
              ln_ffn_g, ln_ffn_b):
    lb_all = jnp.cumsum(jax.nn.softmax(c_lb_raw.astype(jnp.float32), axis=0), axis=0)
    lb_all = lb_all - lb_all[0:1]
    meta = jnp.broadcast_to(meta_tokens[None].astype(x.dtype), (x.shape[0], N_META, D_MODEL))
    h = jnp.concatenate([meta, x], axis=1)
    for layer in range(DEPTH):
        j = layer // 2
        if layer % 2 == 0:
            mix = mixer_gdn_sb(h, ab_w_in[j], ab_conv_w[j], ab_a_log[j], ab_dt_bias[j], ab_gnorm_g[j], ab_w_out[j])
        else:
            mix = mixer_hgrn2(h, c_w_in[j], lb_all[layer], c_gnorm_g[j], c_w_out[j])
        h = layer_norm(DN_ALPHA * h + mix, ln_mix_g[layer], ln_mix_b[layer])
        h = layer_norm(DN_ALPHA * h + squared_relu_mlp(h, mlp_w1[layer], mlp_w2[layer]),
                       ln_ffn_g[layer], ln_ffn_b[layer])
    return h[:, N_META:]
```

```cpp
#include <hip/hip_runtime.h>
#include <hip/hip_cooperative_groups.h>
#include <cstdio>
namespace cg = cooperative_groups;
namespace pg8 {
#define PG8_LAS __attribute__((address_space(3)))
typedef unsigned short bf16_t;
typedef short bf16x8 __attribute__((ext_vector_type(8)));
typedef float f32x4 __attribute__((ext_vector_type(4)));
typedef unsigned u32x4 __attribute__((ext_vector_type(4)));
constexpr int BM = 256, BK = 64, HALF = 128, HTB = HALF * BK * 2  , STAGE_BYTES = 8 * HTB, NXCD = 8, WGM = 8;

__host__ __device__ __forceinline__ int lds_byte(int r, int c) { const int st = (r >> 4) * 2 + (c >> 5), rr = r & 15, cc = c & 31, ob = rr * 64 + cc * 2; return st * 1024 + (ob ^ (((ob >> 9) & 1) << 5)); }
__host__ __device__ __forceinline__ void stage_rc(int b, int& R, int& C) { const int st = b / 1024, sb = b % 1024, swz = sb ^ (((sb >> 9) & 1) << 5); R = (st >> 1) * 16 + swz / 64; C = (st & 1) * 32 + (swz % 64) / 2; }
__host__ __device__ __forceinline__ int perm32(int rho) { const int n = rho >> 4, i = rho & 15; return 8 * (i >> 2) + 4 * n + (i & 3); }

struct Unit { int pm, pn; };
struct Gemm { const bf16_t* A; const bf16_t* Bt; int M, N, K; };

struct StaticOrder {
    int nM, nN, nwg, G, c;
    __host__ __device__ void init(int M, int N, int G_, int c_) { nM = M / BM; nN = N / BM; nwg = nM * nN; G = G_; c = c_; }
    __host__ __device__ bool next(int i, Unit& u) const {
        const long L = (long)i * G + c; if (L >= nwg) return false;
        int wgid = (int)L; { const int q = nwg / NXCD, r = nwg % NXCD, xcd = wgid % NXCD, off = wgid / NXCD; wgid = (xcd < r ? xcd * (q + 1) : r * (q + 1) + (xcd - r) * q) + off; }
        const int nig = WGM * nN, gid = wgid / nig, fm = gid * WGM, gsz = (nM - fm) < WGM ? (nM - fm) : WGM;
        u.pm = fm + ((wgid % nig) % gsz); u.pn = (wgid % nig) / gsz; return true;
    }
    __device__ __forceinline__ void a_ready(const Unit&) const {}
    __device__ __forceinline__ void done(const Unit&) const {}
};
template <class Epi, class Sched, bool STAMP = false>
__device__ __forceinline__ void gemm_phase(PG8_LAS unsigned char* lds, const Gemm g, const Sched& S, const Epi& E, unsigned long long* stamps) {
    int tid_ = threadIdx.x; asm volatile("" : "+v"(tid_)); const int tid = tid_, wid = __builtin_amdgcn_readfirstlane(tid >> 6), lane = tid & 63, wr = wid >> 2, wc = wid & 3, fr = lane & 15, fq = lane >> 4;
    const int K = g.K, nt = K / BK;
    int ts_lo = 0, ts_hi = 0, nts = 0; const unsigned long long rt_entry = STAMP ? (unsigned long long)wall_clock64() : 0ull;
#define PG8_STAMP() do { if (STAMP && wid == 0 && nts < 64) { const unsigned long long _c = (unsigned long long)clock64(); \
        ts_lo = (lane == nts) ? (int)(unsigned)_c : ts_lo; ts_hi = (lane == nts) ? (int)(unsigned)(_c >> 32) : ts_hi; ++nts; } } while (0)
    PG8_STAMP();
    unsigned voffA[2], voffB[2];
#pragma unroll
    for (int i = 0; i < 2; ++i) { int R, C; stage_rc(tid * 16 + i * 8192, R, C); const int Rb = Epi::PERM ? ((R & ~31) + perm32(R & 31)) : R;
        voffA[i] = (unsigned)(R * K + C) * 2u; voffB[i] = (unsigned)(Rb * K + C) * 2u; }
    const size_t kstep = (size_t)(BK * 2);
    const size_t hstep = (size_t)HALF * K * 2;
    const size_t tstep = 2 * hstep;
    const unsigned ldsw = (unsigned)wid * 1024u;
    const int aoff = lds_byte(wr * 64 + fr, fq * 8), boff = lds_byte(wc * 32 + fr, fq * 8);
#define PG8_SA(b, h) (((b) * 2 + (h)) * HTB)
#define PG8_SB(b, h) ((4 + (b) * 2 + (h)) * HTB)
#define PG8_STAGE(bufoff, gbase, voff) do { _Pragma("unroll") for (int _i = 0; _i < 2; ++_i) \
        __builtin_amdgcn_global_load_lds((const unsigned*)((const char*)(gbase) + (voff)[_i]), (PG8_LAS unsigned*)(lds + (bufoff) + ldsw + _i * 8192), 16, 0, 0); } while (0)
#define PG8_LDA(dst, b, h) do { _Pragma("unroll") for (int m = 0; m < 4; ++m) _Pragma("unroll") for (int k = 0; k < 2; ++k) dst[m][k] = *(const PG8_LAS bf16x8*)(lds + PG8_SA(b, h) + aoff + m * 2048 + k * 1024); } while (0)
#define PG8_LDB(dst, b, h) do { _Pragma("unroll") for (int n = 0; n < 2; ++n) _Pragma("unroll") for (int k = 0; k < 2; ++k) dst[n][k] = *(const PG8_LAS bf16x8*)(lds + PG8_SB(b, h) + boff + n * 2048 + k * 1024); } while (0)
#define PG8_MMA(ai, bj, At, Bt) do { __builtin_amdgcn_s_setprio(1); _Pragma("unroll") for (int m = 0; m < 4; ++m) _Pragma("unroll") for (int n = 0; n < 2; ++n) _Pragma("unroll") for (int k = 0; k < 2; ++k) \
        acc[ai][bj][m][n] = __builtin_amdgcn_mfma_f32_16x16x32_bf16(Bt[n][k], At[m][k], acc[ai][bj][m][n], 0, 0, 0); __builtin_amdgcn_s_setprio(0); } while (0)
#define PG8_WAIT_V(n) asm volatile("s_waitcnt vmcnt(" #n ")" ::: "memory")
#define PG8_WAIT_L(n) asm volatile("s_waitcnt lgkmcnt(" #n ")" ::: "memory")
#define PG8_BAR __builtin_amdgcn_s_barrier()
#define PG8_SCHED __builtin_amdgcn_sched_barrier(0)
    Unit cur, nxt; int ui = 0;
    if (!S.next(0, cur)) return;
    f32x4 acc[2][2][4][2];
#pragma unroll
    for (int a = 0; a < 2; ++a)
#pragma unroll
        for (int b = 0; b < 2; ++b)
#pragma unroll
            for (int m = 0; m < 4; ++m)
#pragma unroll
                for (int n = 0; n < 2; ++n) acc[a][b][m][n] = (f32x4){0.f, 0.f, 0.f, 0.f};
    bf16x8 At[4][2], B0[2][2], B1[2][2];
    const char* cA = (const char*)g.A + (size_t)cur.pm * tstep; const char* cB = (const char*)g.Bt + (size_t)cur.pn * tstep;
    S.a_ready(cur);
    PG8_STAGE(PG8_SB(0, 0), cB, voffB); PG8_STAGE(PG8_SA(0, 0), cA, voffA); PG8_STAGE(PG8_SB(0, 1), cB + hstep, voffB); PG8_STAGE(PG8_SA(0, 1), cA + hstep, voffA);
    if (wr == 1) PG8_BAR;
    PG8_WAIT_V(4); PG8_BAR;
    PG8_STAGE(PG8_SB(1, 0), cB + kstep, voffB); PG8_STAGE(PG8_SA(1, 0), cA + kstep, voffA); PG8_STAGE(PG8_SB(1, 1), cB + hstep + kstep, voffB);
    PG8_WAIT_V(6); PG8_BAR;
    PG8_STAMP();
    for (;;) {
        const bool has_next = S.next(ui + 1, nxt);
        const char* nA = has_next ? (const char*)g.A + (size_t)nxt.pm * tstep : cA; const char* nB = has_next ? (const char*)g.Bt + (size_t)nxt.pn * tstep : cB;
        for (int t = 0; t < nt; t += 2) {
            const bool last = (t == nt - 2);
            const char* a1 = cA + (size_t)(t + 1) * kstep;
            const char* a2 = last ? nA : cA + (size_t)(t + 2) * kstep; const char* b2 = last ? nB : cB + (size_t)(t + 2) * kstep;
            const char* a3 = a2 + kstep; const char* b3 = b2 + kstep;
            if (last && has_next) S.a_ready(nxt);
            PG8_LDB(B0, 0, 0); PG8_SCHED; PG8_LDA(At, 0, 0); PG8_STAGE(PG8_SA(1, 1), a1 + hstep, voffA);
            PG8_WAIT_L(8); PG8_BAR; PG8_WAIT_L(0); PG8_MMA(0, 0, At, B0); PG8_BAR; PG8_SCHED;
            PG8_LDB(B1, 0, 1); PG8_STAGE(PG8_SB(0, 0), b2, voffB);
            PG8_BAR; PG8_WAIT_L(0); PG8_MMA(0, 1, At, B1); PG8_BAR;
            PG8_LDA(At, 0, 1); PG8_STAGE(PG8_SA(0, 0), a2, voffA);
            PG8_BAR; PG8_WAIT_L(0); PG8_MMA(1, 0, At, B0); PG8_BAR; PG8_SCHED;
            PG8_STAGE(PG8_SB(0, 1), b2 + hstep, voffB);
            PG8_WAIT_V(6); PG8_BAR; PG8_MMA(1, 1, At, B1); PG8_BAR;
            PG8_LDB(B0, 1, 0); PG8_SCHED; PG8_LDA(At, 1, 0); PG8_STAGE(PG8_SA(0, 1), a2 + hstep, voffA);
            PG8_WAIT_L(8); PG8_BAR; PG8_WAIT_L(0); PG8_MMA(0, 0, At, B0); PG8_BAR; PG8_SCHED;
            PG8_LDB(B1, 1, 1); PG8_STAGE(PG8_SB(1, 0), b3, voffB);
            PG8_BAR; PG8_WAIT_L(0); PG8_MMA(0, 1, At, B1); PG8_BAR;
            PG8_LDA(At, 1, 1); PG8_STAGE(PG8_SA(1, 0), a3, voffA);
            PG8_BAR; PG8_WAIT_L(0); PG8_MMA(1, 0, At, B0); PG8_BAR; PG8_SCHED;
            PG8_STAGE(PG8_SB(1, 1), b3 + hstep, voffB);
            PG8_WAIT_V(6); PG8_BAR; PG8_MMA(1, 1, At, B1); PG8_BAR;
        }
        PG8_STAMP();
        if constexpr (!Epi::AFTER_DRAIN) { E(acc, cur, wr, wc, fr, fq); S.done(cur); }
        PG8_STAMP();
        if (!has_next) break;
#pragma unroll
        for (int a = 0; a < 2; ++a)
#pragma unroll
            for (int b = 0; b < 2; ++b)
#pragma unroll
                for (int m = 0; m < 4; ++m)
#pragma unroll
                    for (int n = 0; n < 2; ++n) acc[a][b][m][n] = (f32x4){0.f, 0.f, 0.f, 0.f};
        cur = nxt; cA = nA; cB = nB; ++ui;
    }
    PG8_WAIT_V(0);
    if (wr == 0) PG8_BAR;
    PG8_BAR;
    if constexpr (Epi::AFTER_DRAIN) { E.fused(acc, cur, wr, wc, fr, fq, lds, wid, lane); S.done(cur); }
    PG8_STAMP();
    if (STAMP && wid == 0) { stamps[lane] = lane < nts ? (((unsigned long long)(unsigned)ts_hi << 32) | (unsigned)ts_lo) : 0ull;
        if (lane == 62) stamps[62] = rt_entry; if (lane == 63) stamps[63] = (unsigned long long)wall_clock64(); }
#undef PG8_STAMP
#undef PG8_SA
#undef PG8_SB
#undef PG8_STAGE
#undef PG8_LDA
#undef PG8_LDB
#undef PG8_MMA
#undef PG8_WAIT_V
#undef PG8_WAIT_L
#undef PG8_BAR
#undef PG8_SCHED
}
}

using pg8::bf16_t; using pg8::bf16x8; using pg8::f32x4; using pg8::u32x4;
typedef float f32x16 __attribute__((ext_vector_type(16)));
typedef float f32x2v __attribute__((ext_vector_type(2)));
typedef __bf16 bf2v __attribute__((ext_vector_type(2)));
typedef unsigned u32x2 __attribute__((ext_vector_type(2)));
#define DI __device__ __forceinline__
#define MFMA32(a, b, c) __builtin_amdgcn_mfma_f32_32x32x16_bf16((a), (b), (c), 0, 0, 0)

constexpr int NB = 8, SEQ = 4096, PADF = 112, XOFF = 128, TT = 4224, MROWS = NB * TT, DM = 1024, DFF = 4096;
constexpr int N0 = 3840, N1 = 4096, NCH = TT / 64;
constexpr float DN_ALPHA = 1.4142135623730951f;
constexpr int LDS_BYTES = 131072;
constexpr int SB_ITEMS = 129 * 64;

constexpr size_t WS_CTL = 0;
constexpr size_t WS_WAB = 4096;
constexpr size_t WS_WABO = WS_WAB + (size_t)N0 * 1024 * 2;
constexpr size_t WS_WC = WS_WABO + (size_t)1024 * 1024 * 2;
constexpr size_t WS_WCO = WS_WC + (size_t)4096 * 1024 * 2;
constexpr size_t WS_W1 = WS_WCO + (size_t)1024 * 1024 * 2;
constexpr size_t WS_W2 = WS_W1 + (size_t)2 * 4096 * 1024 * 2;
constexpr size_t WS_H16 = WS_W2 + (size_t)2 * 4096 * 1024 * 2;
constexpr size_t WS_R1 = WS_H16 + (size_t)MROWS * 1024 * 2;
constexpr size_t WS_MIX = WS_R1 + (size_t)MROWS * 4096 * 2;
constexpr size_t WS_SIDE = WS_MIX + (size_t)MROWS * 1024 * 2;
constexpr size_t WS_KDT = WS_SIDE + (size_t)NB * 128 * 1024 * 4;
constexpr size_t WS_GA = WS_KDT + (size_t)MROWS * 512 * 2;
constexpr size_t WS_GT = WS_GA + (size_t)MROWS * 256 * 2;
constexpr size_t WS_END = WS_GT + 16384;
constexpr size_t DO_W = 0, DO_QD = (size_t)MROWS * 512 * 2, DO_UT = 2 * DO_QD;
constexpr size_t DO_HA = 0, DO_DVEC = (size_t)NB * 8 * NCH * 4096 * 2;

struct P { const float* in[18]; float* out; unsigned char* ws; int ph_lo, ph_hi; };

DI int my_tid() { int t = threadIdx.x; asm volatile("" : "+v"(t)); return t; }
DI float bf2f(unsigned short b) { return __uint_as_float(((unsigned)b) << 16); }
DI unsigned pack2(float lo, float hi) { f32x2v v = {lo, hi}; bf2v b = __builtin_convertvector(v, bf2v); return __builtin_bit_cast(unsigned, b); }
DI unsigned short f2bf(float x) { return (unsigned short)(pack2(x, 0.f) & 0xffffu); }
DI int crow(int reg, int h) { return (reg & 3) + 8 * (reg >> 2) + 4 * h; }
DI float sigmoidf_(float x) { return 1.f / (1.f + __expf(-x)); }
DI float siluf_(float x) { return x / (1.f + __expf(-x)); }
DI float softplusf_(float x) { return fmaxf(x, 0.f) + __logf(1.f + __expf(-fabsf(x))); }
DI float lo16(unsigned u) { return __uint_as_float(u << 16); }
DI float hi16(unsigned u) { return __uint_as_float(u & 0xffff0000u); }
DI bf16x8 pack8(const f32x16& x, int s) {
    u32x4 p;
    p[0] = pack2(x[8 * s + 0], x[8 * s + 1]); p[1] = pack2(x[8 * s + 2], x[8 * s + 3]);
    p[2] = pack2(x[8 * s + 4], x[8 * s + 5]); p[3] = pack2(x[8 * s + 6], x[8 * s + 7]);
    return __builtin_bit_cast(bf16x8, p);
}
DI bf16x8 loadA(const bf16_t* p) {
    u32x2 a = *(const u32x2*)p, b = *(const u32x2*)(p + 8);
    u32x4 v = {a[0], a[1], b[0], b[1]};
    return __builtin_bit_cast(bf16x8, v);
}
DI float* yrow(float* dout, float* side, int row) {
    const int b = row / TT, pos = row - b * TT;
    return pos >= XOFF ? dout + ((size_t)b * SEQ + (pos - XOFF)) * DM : side + ((size_t)b * XOFF + pos) * DM;
}

struct EpiStore {
    static constexpr bool PERM = true, AFTER_DRAIN = false;
    bf16_t* O; int ldc; int act;
    DI void operator()(const f32x4 (&acc)[2][2][4][2], const pg8::Unit& u, int wr, int wc, int fr, int fq) const {
        const int row0 = u.pm * 256 + wr * 64 + fr, col0 = u.pn * 256 + wc * 32 + 8 * fq;
#pragma unroll
        for (int ai = 0; ai < 2; ++ai)
#pragma unroll
            for (int m = 0; m < 4; ++m) {
                bf16_t* rowp = O + (size_t)(row0 + ai * 128 + m * 16) * ldc + col0;
#pragma unroll
                for (int bj = 0; bj < 2; ++bj) {
                    f32x4 v0 = acc[ai][bj][m][0], v1 = acc[ai][bj][m][1];
                    if (act) {
#pragma unroll
                        for (int e = 0; e < 4; ++e) { float a = fmaxf(v0[e], 0.f), b = fmaxf(v1[e], 0.f); v0[e] = a * a; v1[e] = b * b; }
                    }
                    u32x4 o = {pack2(v0[0], v0[1]), pack2(v0[2], v0[3]), pack2(v1[0], v1[1]), pack2(v1[2], v1[3])};
                    *(u32x4*)(rowp + bj * 128) = o;
                }
            }
    }
};
struct EpiResid {
    static constexpr bool PERM = false, AFTER_DRAIN = false;
    const bf16_t* H; float* dout; float* side;
    DI void operator()(const f32x4 (&acc)[2][2][4][2], const pg8::Unit& u, int wr, int wc, int fr, int fq) const {
        const int row0 = u.pm * 256 + wr * 64 + fr, col0 = u.pn * 256 + wc * 32 + 4 * fq;
#pragma unroll
        for (int ai = 0; ai < 2; ++ai)
#pragma unroll
            for (int m = 0; m < 4; ++m) {
                const int row = row0 + ai * 128 + m * 16;
                float* yp = yrow(dout, side, row) + col0;
                const bf16_t* hp = H + (size_t)row * DM + col0;
#pragma unroll
                for (int bj = 0; bj < 2; ++bj)
#pragma unroll
                    for (int n = 0; n < 2; ++n) {
                        const u32x2 hv = *(const u32x2*)(hp + bj * 128 + n * 16);
                        f32x4 a = acc[ai][bj][m][n];
                        f32x4 y = {DN_ALPHA * lo16(hv[0]) + a[0], DN_ALPHA * hi16(hv[0]) + a[1], DN_ALPHA * lo16(hv[1]) + a[2], DN_ALPHA * hi16(hv[1]) + a[3]};
                        *(f32x4*)(yp + bj * 128 + n * 16) = y;
                    }
            }
    }
};

DI void prep_phase(const P& p, unsigned char* lds) {
    float* tile = (float*)lds;
    const int tid = my_tid();
    constexpr int NT0 = 16 * 60, NT1 = 16 * 16, NT2 = 16 * 64, NT3 = 16 * 16, NT4 = 16 * 64, NT5 = 64 * 16;
    constexpr int C0 = NT0, C1 = C0 + NT1, C2 = C1 + NT2, C3 = C2 + NT3, C4 = C3 + 2 * NT4, C5 = C4 + 2 * NT5;
    for (int tix = blockIdx.x; tix < C5; tix += gridDim.x) {
        const float* src; bf16_t* dst; int K, Ns, Nd, loc, remap = 0;
        if (tix < C0) { src = p.in[2]; dst = (bf16_t*)(p.ws + WS_WAB); K = 1024; Ns = 3592; Nd = N0; loc = tix; remap = 1; }
        else if (tix < C1) { src = p.in[7]; dst = (bf16_t*)(p.ws + WS_WABO); K = 1024; Ns = 1024; Nd = 1024; loc = tix - C0; }
        else if (tix < C2) { src = p.in[8]; dst = (bf16_t*)(p.ws + WS_WC); K = 1024; Ns = 4096; Nd = 4096; loc = tix - C1; }
        else if (tix < C3) { src = p.in[11]; dst = (bf16_t*)(p.ws + WS_WCO); K = 1024; Ns = 1024; Nd = 1024; loc = tix - C2; }
        else if (tix < C4) { int l = (tix - C3) / NT4; src = p.in[14] + (size_t)l * 1024 * 4096; dst = (bf16_t*)(p.ws + WS_W1) + (size_t)l * 4096 * 1024; K = 1024; Ns = 4096; Nd = 4096; loc = (tix - C3) % NT4; }
        else { int l = (tix - C4) / NT5; src = p.in[15] + (size_t)l * 4096 * 1024; dst = (bf16_t*)(p.ws + WS_W2) + (size_t)l * 1024 * 4096; K = 4096; Ns = 1024; Nd = 1024; loc = (tix - C4) % NT5; }
        const int ntn = Nd / 64, kt = loc / ntn, nt = loc % ntn, k0 = kt * 64, n0 = nt * 64;
#pragma unroll
        for (int it = 0; it < 2; ++it) {
            const int i = (tid >> 4) + 32 * it, j = (tid & 15) * 4, n = n0 + j;
            int ns = n; bool valid = true;
            if (remap) { if (n < 2048) ns = n; else if (n < 3584) ns = n + 8; else if (n < 3592) ns = n - 3584 + 2048; else valid = false; }
            f32x4 v = {0.f, 0.f, 0.f, 0.f};
            if (valid) v = *(const f32x4*)(src + (size_t)(k0 + i) * Ns + ns);
            tile[i * 65 + j] = v[0]; tile[i * 65 + j + 1] = v[1]; tile[i * 65 + j + 2] = v[2]; tile[i * 65 + j + 3] = v[3];
        }
        __syncthreads();
        {
            const int j = tid >> 3, i0 = (tid & 7) * 8;
            u32x4 o;
#pragma unroll
            for (int e = 0; e < 4; ++e) o[e] = pack2(tile[(i0 + 2 * e) * 65 + j], tile[(i0 + 2 * e + 1) * 65 + j]);
            *(u32x4*)(dst + (size_t)(n0 + j) * K + k0 + i0) = o;
        }
        __syncthreads();
    }
    bf16_t* h16 = (bf16_t*)(p.ws + WS_H16);
    const float* x = p.in[0]; const float* meta = p.in[1];
    for (int uidx = blockIdx.x * 512 + tid; uidx < MROWS * 128; uidx += gridDim.x * 512) {
        const int row = uidx >> 7, c0 = (uidx & 127) * 8, b = row / TT, pos = row - b * TT;
        u32x4 o = {0u, 0u, 0u, 0u};
        if (pos >= PADF) {
            const float* s = pos >= XOFF ? x + ((size_t)b * SEQ + (pos - XOFF)) * DM + c0 : meta + (size_t)(pos - PADF) * DM + c0;
            const f32x4 a = *(const f32x4*)s, c = *(const f32x4*)(s + 4);
            o[0] = pack2(a[0], a[1]); o[1] = pack2(a[2], a[3]); o[2] = pack2(c[0], c[1]); o[3] = pack2(c[2], c[3]);
        }
        *(u32x4*)(h16 + (size_t)row * DM + c0) = o;
    }
}

DI float wave_sum(float v) {
#pragma unroll
    for (int o = 32; o >= 1; o >>= 1) v += __shfl_xor(v, o);
    return v;
}
DI void ln_phase(const P& p, const float* g, const float* bb, int final_) {
    const int tid = my_tid(), lane = tid & 63, gw = blockIdx.x * 8 + (tid >> 6), nw = gridDim.x * 8;
    float* side = (float*)(p.ws + WS_SIDE); bf16_t* h16 = (bf16_t*)(p.ws + WS_H16);
    f32x4 gv[4], bv[4];
#pragma unroll
    for (int i = 0; i < 4; ++i) { gv[i] = *(const f32x4*)(g + i * 256 + lane * 4); bv[i] = *(const f32x4*)(bb + i * 256 + lane * 4); }
    for (int row = gw; row < MROWS; row += nw) {
        const int b = row / TT, pos = row - b * TT;
        if (final_ && pos < XOFF) continue;
        float* y = yrow(p.out, side, row);
        f32x4 v[4]; float s = 0.f;
#pragma unroll
        for (int i = 0; i < 4; ++i) { v[i] = *(const f32x4*)(y + i * 256 + lane * 4); s += v[i][0] + v[i][1] + v[i][2] + v[i][3]; }
        const float mean = wave_sum(s) * (1.f / 1024.f);
        float q = 0.f;
#pragma unroll
        for (int i = 0; i < 4; ++i)
#pragma unroll
            for (int e = 0; e < 4; ++e) { const float d = v[i][e] - mean; q += d * d; }
        const float rstd = rsqrtf(wave_sum(q) * (1.f / 1024.f) + 1e-5f);
#pragma unroll
        for (int i = 0; i < 4; ++i) {
            f32x4 o;
#pragma unroll
            for (int e = 0; e < 4; ++e) o[e] = (v[i][e] - mean) * rstd * gv[i][e] + bv[i][e];
            if (final_) *(f32x4*)(y + i * 256 + lane * 4) = o;
            else {
                u32x2 w = {pack2(o[0], o[1]), pack2(o[2], o[3])};
                if (pos < PADF) { w[0] = 0u; w[1] = 0u; }
                *(u32x2*)(h16 + (size_t)row * DM + i * 256 + lane * 4) = w;
            }
        }
    }
}

DI void gdn_prep_item(const P& p, int item, unsigned char* lds) {
    const int tid = my_tid(), lane = tid & 63, wv = tid >> 6, r = lane & 31, hh = lane >> 5;
    const int n = item % NCH, hb = item / NCH, h = hb & 3, b = hb >> 2;
    const int row0 = b * TT + n * 64;
    const bf16_t* proj = (const bf16_t*)(p.ws + WS_R1);
    bf16_t* qs = (bf16_t*)lds;
    bf16_t* ks = qs + 64 * 136;
    bf16_t* vbT = ks + 64 * 136;
    bf16_t* kbT = vbT + 128 * 72;
    bf16_t* kdTs = kbT + 128 * 72;
    bf16_t* Tm = kdTs + 128 * 72;
    float* Mm = (float*)(Tm + 64 * 72);
    float* gcs = Mm + 64 * 64; float* betas = gcs + 64;
    bf16_t* Wg = (bf16_t*)((unsigned char*)p.out + DO_W); bf16_t* QD = (bf16_t*)((unsigned char*)p.out + DO_QD); bf16_t* UT = (bf16_t*)((unsigned char*)p.out + DO_UT);
    bf16_t* KDT = (bf16_t*)(p.ws + WS_KDT); bf16_t* GA = (bf16_t*)(p.ws + WS_GA); float* GT = (float*)(p.ws + WS_GT);
    const float* conv_w = p.in[3];
    if (tid < 64) {
        const size_t ro = (size_t)(row0 + tid) * N0;
        const float ba = bf2f(proj[ro + 3584 + h]), aa = bf2f(proj[ro + 3588 + h]);
        const float beta = sigmoidf_(ba);
        float g = -__expf(p.in[4][h]) * softplusf_(aa + p.in[5][h]);
#pragma unroll
        for (int o = 1; o < 64; o <<= 1) { const float t = __shfl_up(g, o); if (lane >= o) g += t; }
        gcs[tid] = g; betas[tid] = beta;
    }
    __syncthreads();
    const float gl = gcs[63];
    if (tid == 0) GT[item] = __expf(gl);
#pragma unroll 1
    for (int it = 0; it < 6; ++it) {
        const int idx = it * 512 + tid, t = idx / 48, g48 = idx - t * 48, part = g48 >> 4, c0 = (g48 & 15) * 8;
        const int ch = part * 512 + h * 128 + c0, pos = n * 64 + t;
        float acc[8];
#pragma unroll
        for (int e = 0; e < 8; ++e) acc[e] = 0.f;
#pragma unroll
        for (int k = 0; k < 4; ++k) {
            const int pp = pos - 3 + k;
            if (pp >= 0) {
                const u32x4 xv = *(const u32x4*)(proj + (size_t)(b * TT + pp) * N0 + ch);
                const f32x4 w0 = *(const f32x4*)(conv_w + k * 1536 + ch), w1 = *(const f32x4*)(conv_w + k * 1536 + ch + 4);
                acc[0] += w0[0] * lo16(xv[0]); acc[1] += w0[1] * hi16(xv[0]); acc[2] += w0[2] * lo16(xv[1]); acc[3] += w0[3] * hi16(xv[1]);
                acc[4] += w1[0] * lo16(xv[2]); acc[5] += w1[1] * hi16(xv[2]); acc[6] += w1[2] * lo16(xv[3]); acc[7] += w1[3] * hi16(xv[3]);
            }
        }
        float ss = 0.f;
#pragma unroll
        for (int e = 0; e < 8; ++e) { acc[e] = siluf_(acc[e]); ss += acc[e] * acc[e]; }
        ss += __shfl_xor(ss, 1); ss += __shfl_xor(ss, 2); ss += __shfl_xor(ss, 4); ss += __shfl_xor(ss, 8);
        const float gct = gcs[t], bet = betas[t];
        if (part < 2) {
            const float sc = rsqrtf(ss + 1e-6f) * (part == 0 ? 0.08838834764831845f : 1.f);
#pragma unroll
            for (int e = 0; e < 8; ++e) acc[e] *= sc;
        }
        if (part == 0) {
            u32x4 o = {pack2(acc[0], acc[1]), pack2(acc[2], acc[3]), pack2(acc[4], acc[5]), pack2(acc[6], acc[7])};
            *(u32x4*)(qs + t * 136 + c0) = o;
            const float eg = __expf(gct);
            u32x4 o2 = {pack2(acc[0] * eg, acc[1] * eg), pack2(acc[2] * eg, acc[3] * eg), pack2(acc[4] * eg, acc[5] * eg), pack2(acc[6] * eg, acc[7] * eg)};
            *(u32x4*)(QD + (size_t)(row0 + t) * 512 + h * 128 + c0) = o2;
        } else if (part == 1) {
            u32x4 o = {pack2(acc[0], acc[1]), pack2(acc[2], acc[3]), pack2(acc[4], acc[5]), pack2(acc[6], acc[7])};
            *(u32x4*)(ks + t * 136 + c0) = o;
            const float f1 = bet * __expf(gct), f2 = __expf(gl - gct);
#pragma unroll
            for (int e = 0; e < 8; ++e) { kbT[(c0 + e) * 72 + t] = f2bf(acc[e] * f1); kdTs[(c0 + e) * 72 + t] = f2bf(acc[e] * f2); }
        } else {
#pragma unroll
            for (int e = 0; e < 8; ++e) vbT[(c0 + e) * 72 + t] = f2bf(acc[e] * bet);
        }
    }
    __syncthreads();
    {
        const int which = wv >> 2, mi = (wv >> 1) & 1, ni = wv & 1;
        const bf16_t* Ap = (which ? qs : ks) + (32 * mi + r) * 136 + 8 * hh;
        const bf16_t* Bp = ks + (32 * ni + r) * 136 + 8 * hh;
        f32x16 acc;
#pragma unroll
        for (int j = 0; j < 16; ++j) acc[j] = 0.f;
#pragma unroll
        for (int s = 0; s < 8; ++s) acc = MFMA32(*(const bf16x8*)(Ap + 16 * s), *(const bf16x8*)(Bp + 16 * s), acc);
        const int jt = 32 * ni + r; const float gj = gcs[jt];
#pragma unroll
        for (int j = 0; j < 16; ++j) {
            const int i = 32 * mi + crow(j, hh);
            const float dec = __expf(fminf(gcs[i] - gj, 0.f));
            if (which == 0) Mm[i * 64 + jt] = (jt < i) ? betas[i] * acc[j] * dec : 0.f;
            else GA[(size_t)item * 4096 + i * 64 + jt] = f2bf((jt <= i) ? acc[j] * dec : 0.f);
        }
    }
    __syncthreads();
    if (wv == 0) {
        float x[64];
        int vz = 0; asm volatile("" : "+v"(vz));
        const float* Mv = Mm + (vz << 2);
#pragma unroll
        for (int i = 0; i < 64; ++i) {
            float a = (i == lane) ? 1.f : 0.f;
#pragma unroll
            for (int q = 0; q < (i + 3) / 4; ++q) {
                const f32x4 m = *(const f32x4*)(Mv + i * 64 + 4 * q);
#pragma unroll
                for (int e = 0; e < 4; ++e) if (4 * q + e < i) a -= m[e] * x[4 * q + e];
            }
            x[i] = a;
        }
#pragma unroll
        for (int i = 0; i < 64; ++i) Tm[i * 72 + lane] = f2bf(x[i]);
    }
    __syncthreads();
    {
        const int dt = wv >> 1, it = wv & 1;
        f32x16 au, aw;
#pragma unroll
        for (int j = 0; j < 16; ++j) { au[j] = 0.f; aw[j] = 0.f; }
#pragma unroll
        for (int s = 0; s < 4; ++s) {
            const bf16x8 bT = *(const bf16x8*)(Tm + (32 * it + r) * 72 + 16 * s + 8 * hh);
            au = MFMA32(*(const bf16x8*)(vbT + (32 * dt + r) * 72 + 16 * s + 8 * hh), bT, au);
            aw = MFMA32(*(const bf16x8*)(kbT + (32 * dt + r) * 72 + 16 * s + 8 * hh), bT, aw);
        }
#pragma unroll
        for (int j = 0; j < 16; ++j) UT[(size_t)item * 8192 + (32 * dt + crow(j, hh)) * 64 + 32 * it + r] = f2bf(au[j]);
#pragma unroll
        for (int g = 0; g < 4; ++g) {
            u32x2 o = {pack2(aw[4 * g], aw[4 * g + 1]), pack2(aw[4 * g + 2], aw[4 * g + 3])};
            *(u32x2*)(Wg + (size_t)(row0 + 32 * it + r) * 512 + h * 128 + 32 * dt + 8 * g + 4 * hh) = o;
        }
    }
#pragma unroll
    for (int it = 0; it < 2; ++it) {
        const int c = it * 512 + tid, dk = c >> 3, t8 = (c & 7) * 8;
        *(u32x4*)(KDT + (size_t)item * 8192 + dk * 64 + t8) = *(const u32x4*)(kdTs + dk * 72 + t8);
    }
    __syncthreads();
}

DI void hg_prep_item(const P& p, int item, unsigned char* lds) {
    const int tid = my_tid(), lane = tid & 63, wv = tid >> 6, r = lane & 31, hh = lane >> 5;
    const int n = item % NCH, hb = item / NCH, h = hb & 7, b = hb >> 3;
    const int row0 = b * TT + n * 64;
    bf16_t* proj = (bf16_t*)(p.ws + WS_R1);
    float* lfs = (float*)lds;
    bf16_t* qs = (bf16_t*)(lfs + 64 * 132);
    bf16_t* ks = qs + 64 * 136;
    bf16_t* kdTs = ks + 64 * 136;
    bf16_t* vTs = kdTs + 128 * 72;
    float* blast = (float*)(vTs + 128 * 72);
    bf16_t* HA = (bf16_t*)((unsigned char*)p.out + DO_HA); float* DVEC = (float*)((unsigned char*)p.out + DO_DVEC);
    const float* lbr = p.in[9];
#pragma unroll
    for (int it = 0; it < 2; ++it) {
        const int idx = it * 512 + tid, t = idx >> 4, c0 = (idx & 15) * 8;
        const bf16_t* rp = proj + (size_t)(row0 + t) * N1 + h * 128 + c0;
        const u32x4 q8 = *(const u32x4*)rp, f8 = *(const u32x4*)(rp + 1024), i8 = *(const u32x4*)(rp + 2048);
        float kk[8], qq[8];
#pragma unroll
        for (int e = 0; e < 8; ++e) {
            const int c = c0 + e;
            const float fv = (e & 1) ? hi16(f8[e >> 1]) : lo16(f8[e >> 1]);
            const float qv = (e & 1) ? hi16(q8[e >> 1]) : lo16(q8[e >> 1]);
            const float lb = sigmoidf_(lbr[1024 + h * 128 + c] - lbr[h * 128 + c]);
            const float sg = sigmoidf_(fv);
            const float fg = lb + (1.f - lb) * sg;
            lfs[t * 132 + c] = __logf(fg);
            kk[e] = (1.f - lb) * (1.f - sg);
            qq[e] = siluf_(qv);
            vTs[c * 72 + t] = (unsigned short)((e & 1) ? (i8[e >> 1] >> 16) : (i8[e >> 1] & 0xffffu));
        }
        u32x4 ko = {pack2(kk[0], kk[1]), pack2(kk[2], kk[3]), pack2(kk[4], kk[5]), pack2(kk[6], kk[7])};
        u32x4 qo = {pack2(qq[0], qq[1]), pack2(qq[2], qq[3]), pack2(qq[4], qq[5]), pack2(qq[6], qq[7])};
        *(u32x4*)(ks + t * 136 + c0) = ko; *(u32x4*)(qs + t * 136 + c0) = qo;
    }
    __syncthreads();
    if (tid < 128) {
        float run = 0.f;
#pragma unroll 8
        for (int t = 0; t < 64; ++t) { run += lfs[t * 132 + tid]; lfs[t * 132 + tid] = run; }
        blast[tid] = run; DVEC[(size_t)item * 128 + tid] = __expf(run);
    }
    __syncthreads();
#pragma unroll
    for (int it = 0; it < 2; ++it) {
        const int idx = it * 512 + tid, t = idx >> 4, c0 = (idx & 15) * 8;
        const u32x4 q8 = *(const u32x4*)(qs + t * 136 + c0), k8 = *(const u32x4*)(ks + t * 136 + c0);
        float qv[8], kh[8];
#pragma unroll
        for (int e = 0; e < 8; ++e) {
            const int c = c0 + e;
            const float bb = lfs[t * 132 + c];
            const float kk = (e & 1) ? hi16(k8[e >> 1]) : lo16(k8[e >> 1]);
            const float qq = (e & 1) ? hi16(q8[e >> 1]) : lo16(q8[e >> 1]);
            qv[e] = qq * __expf(bb); kh[e] = kk * __expf(-bb);
            kdTs[c * 72 + t] = f2bf(kk * __expf(blast[c] - bb));
        }
        u32x4 qo = {pack2(qv[0], qv[1]), pack2(qv[2], qv[3]), pack2(qv[4], qv[5]), pack2(qv[6], qv[7])};
        u32x4 ko = {pack2(kh[0], kh[1]), pack2(kh[2], kh[3]), pack2(kh[4], kh[5]), pack2(kh[6], kh[7])};
        *(u32x4*)(qs + t * 136 + c0) = qo; *(u32x4*)(ks + t * 136 + c0) = ko;
        *(u32x4*)(proj + (size_t)(row0 + t) * N1 + h * 128 + c0) = qo;
    }
    __syncthreads();
    if (wv < 4) {
        const int mi = wv >> 1, ni = wv & 1;
        const bf16_t* Ap = qs + (32 * mi + r) * 136 + 8 * hh;
        const bf16_t* Bp = ks + (32 * ni + r) * 136 + 8 * hh;
        f32x16 acc;
#pragma unroll
        for (int j = 0; j < 16; ++j) acc[j] = 0.f;
#pragma unroll
        for (int s = 0; s < 8; ++s) acc = MFMA32(*(const bf16x8*)(Ap + 16 * s), *(const bf16x8*)(Bp + 16 * s), acc);
        const int jt = 32 * ni + r;
#pragma unroll
        for (int j = 0; j < 16; ++j) { const int i = 32 * mi + crow(j, hh); HA[(size_t)item * 4096 + i * 64 + jt] = f2bf((jt <= i) ? acc[j] : 0.f); }
    }
#pragma unroll
    for (int it = 0; it < 2; ++it) {
        const int c = it * 512 + tid, dk = c >> 3, t8 = (c & 7) * 8, lin = dk * 64 + t8, prow = lin >> 7, pcol = lin & 127;
        bf16_t* dp = proj + (size_t)(row0 + prow) * N1 + h * 128 + pcol;
        *(u32x4*)(dp + 1024) = *(const u32x4*)(kdTs + dk * 72 + t8);
        *(u32x4*)(dp + 2048) = *(const u32x4*)(vTs + dk * 72 + t8);
    }
    __syncthreads();
}

template <int KIND>
DI void scan_chain(const P& p, int chain, unsigned char* lds) {
    const int tid = my_tid(), lane = tid & 63, wv = tid >> 6, r = lane & 31, hh = lane >> 5;
    float* obuf = (float*)lds;
    const int h = KIND == 0 ? (chain & 3) : (chain & 7), b = KIND == 0 ? (chain >> 2) : (chain >> 3);
    const size_t rb = (size_t)b * TT;
    const bf16_t* r1 = (const bf16_t*)(p.ws + WS_R1);
    const bf16_t *qd, *wq, *Am, *kdT, *uT, *zg; const float *dvec, *gn; int qld, zld; size_t cs; int s2;
    if (KIND == 0) {
        qd = (const bf16_t*)((unsigned char*)p.out + DO_QD) + rb * 512 + h * 128; wq = (const bf16_t*)((unsigned char*)p.out + DO_W) + rb * 512 + h * 128; qld = 512;
        Am = (const bf16_t*)(p.ws + WS_GA) + (size_t)chain * NCH * 4096;
        kdT = (const bf16_t*)(p.ws + WS_KDT) + (size_t)chain * NCH * 8192; uT = (const bf16_t*)((unsigned char*)p.out + DO_UT) + (size_t)chain * NCH * 8192; cs = 8192; s2 = 128;
        dvec = (const float*)(p.ws + WS_GT) + (size_t)chain * NCH; zg = r1 + rb * N0 + 1536 + h * 128; zld = N0; gn = p.in[6];
    } else {
        qd = r1 + rb * N1 + h * 128; wq = qd; qld = N1;
        Am = (const bf16_t*)((unsigned char*)p.out + DO_HA) + (size_t)chain * NCH * 4096;
        kdT = r1 + rb * N1 + 1024 + h * 128; uT = r1 + rb * N1 + 2048 + h * 128; cs = (size_t)64 * N1; s2 = N1;
        dvec = (const float*)((unsigned char*)p.out + DO_DVEC) + (size_t)chain * NCH * 128; zg = r1 + rb * N1 + 3072 + h * 128; zld = N1; gn = p.in[10];
    }
    bf16_t* outp = (bf16_t*)(p.ws + WS_MIX) + rb * DM + h * 128;
    f32x16 S[4];
#pragma unroll
    for (int kt = 0; kt < 4; ++kt)
#pragma unroll
        for (int j = 0; j < 16; ++j) S[kt][j] = 0.f;
    const int dv0 = 32 * wv;
#pragma unroll 1
    for (int n = 1; n < NCH; ++n) {
        const int t0 = n * 64;
        if (wv < 4) {
            bf16x8 Sb[4][2];
#pragma unroll
            for (int kt = 0; kt < 4; ++kt) { Sb[kt][0] = pack8(S[kt], 0); Sb[kt][1] = pack8(S[kt], 1); }
            f32x16 vn[2], o[2];
            const int dvi = dv0 + r;
            const bf16_t* up = uT + (size_t)n * cs + (size_t)(dvi >> 1) * s2 + (dvi & 1) * 64 + 4 * hh;
#pragma unroll
            for (int mt = 0; mt < 2; ++mt)
#pragma unroll
                for (int g = 0; g < 4; ++g) {
                    const u32x2 raw = *(const u32x2*)(up + 32 * mt + 8 * g);
                    vn[mt][4 * g] = lo16(raw[0]); vn[mt][4 * g + 1] = hi16(raw[0]); vn[mt][4 * g + 2] = lo16(raw[1]); vn[mt][4 * g + 3] = hi16(raw[1]);
                }
            if (KIND == 0) {
#pragma unroll
                for (int mt = 0; mt < 2; ++mt) {
                    f32x16 a;
#pragma unroll
                    for (int j = 0; j < 16; ++j) a[j] = 0.f;
                    const bf16_t* wp = wq + (size_t)(t0 + 32 * mt + r) * qld + 4 * hh;
#pragma unroll
                    for (int kt = 0; kt < 4; ++kt)
#pragma unroll
                        for (int s = 0; s < 2; ++s) a = MFMA32(loadA(wp + 32 * kt + 16 * s), Sb[kt][s], a);
#pragma unroll
                    for (int j = 0; j < 16; ++j) vn[mt][j] -= a[j];
                }
            }
#pragma unroll
            for (int mt = 0; mt < 2; ++mt) {
#pragma unroll
                for (int j = 0; j < 16; ++j) o[mt][j] = 0.f;
                const bf16_t* qp = qd + (size_t)(t0 + 32 * mt + r) * qld + 4 * hh;
#pragma unroll
                for (int kt = 0; kt < 4; ++kt)
#pragma unroll
                    for (int s = 0; s < 2; ++s) o[mt] = MFMA32(loadA(qp + 32 * kt + 16 * s), Sb[kt][s], o[mt]);
            }
            bf16x8 vb[2][2];
#pragma unroll
            for (int mt = 0; mt < 2; ++mt) { vb[mt][0] = pack8(vn[mt], 0); vb[mt][1] = pack8(vn[mt], 1); }
            const bf16_t* ap = Am + (size_t)n * 4096 + 4 * hh;
#pragma unroll
            for (int mt = 0; mt < 2; ++mt)
#pragma unroll
                for (int mt2 = 0; mt2 <= mt; ++mt2)
#pragma unroll
                    for (int s = 0; s < 2; ++s) o[mt] = MFMA32(loadA(ap + (32 * mt + r) * 64 + 32 * mt2 + 16 * s), vb[mt2][s], o[mt]);
#pragma unroll
            for (int kt = 0; kt < 4; ++kt) {
                if (KIND == 0) {
                    const float d = dvec[n];
#pragma unroll
                    for (int j = 0; j < 16; ++j) S[kt][j] *= d;
                } else {
#pragma unroll
                    for (int g = 0; g < 4; ++g) {
                        const f32x4 d4 = *(const f32x4*)(dvec + (size_t)n * 128 + 32 * kt + 8 * g + 4 * hh);
#pragma unroll
                        for (int e = 0; e < 4; ++e) S[kt][4 * g + e] *= d4[e];
                    }
                }
                const int dk = 32 * kt + r;
                const bf16_t* kp = kdT + (size_t)n * cs + (size_t)(dk >> 1) * s2 + (dk & 1) * 64 + 4 * hh;
#pragma unroll
                for (int mt2 = 0; mt2 < 2; ++mt2)
#pragma unroll
                    for (int s = 0; s < 2; ++s) S[kt] = MFMA32(loadA(kp + 32 * mt2 + 16 * s), vb[mt2][s], S[kt]);
            }
            float* ob = obuf + (n & 1) * 64 * 132 + dv0 + r;
#pragma unroll
            for (int mt = 0; mt < 2; ++mt)
#pragma unroll
                for (int j = 0; j < 16; ++j) ob[(32 * mt + crow(j, hh)) * 132] = o[mt][j];
        }
        __syncthreads();
        {
            const int row = tid >> 3, c0 = (tid & 7) * 16;
            const float* ob = obuf + (n & 1) * 64 * 132 + row * 132 + c0;
            f32x4 v[4]; float ss = 0.f;
#pragma unroll
            for (int i = 0; i < 4; ++i) { v[i] = *(const f32x4*)(ob + 4 * i); ss += v[i][0] * v[i][0] + v[i][1] * v[i][1] + v[i][2] * v[i][2] + v[i][3] * v[i][3]; }
            ss += __shfl_xor(ss, 1); ss += __shfl_xor(ss, 2); ss += __shfl_xor(ss, 4);
            const float inv = rsqrtf(ss * (1.f / 128.f) + 1e-6f);
            const bf16_t* zp = zg + (size_t)(t0 + row) * zld + c0;
            const u32x4 z0 = *(const u32x4*)zp, z1 = *(const u32x4*)(zp + 8);
            u32x4 o0, o1;
#pragma unroll
            for (int i = 0; i < 4; ++i) {
                const f32x4 g4 = *(const f32x4*)(gn + c0 + 4 * i);
                const unsigned za = (i < 2) ? z0[2 * i] : z1[2 * i - 4], zb = (i < 2) ? z0[2 * i + 1] : z1[2 * i - 3];
                const float y0 = v[i][0] * inv * g4[0] * siluf_(lo16(za)), y1 = v[i][1] * inv * g4[1] * siluf_(hi16(za));
                const float y2 = v[i][2] * inv * g4[2] * siluf_(lo16(zb)), y3 = v[i][3] * inv * g4[3] * siluf_(hi16(zb));
                if (i < 2) { o0[2 * i] = pack2(y0, y1); o0[2 * i + 1] = pack2(y2, y3); } else { o1[2 * i - 4] = pack2(y0, y1); o1[2 * i - 3] = pack2(y2, y3); }
            }
            bf16_t* op = outp + (size_t)(t0 + row) * DM + c0;
            *(u32x4*)op = o0; *(u32x4*)(op + 8) = o1;
        }
    }
    __syncthreads();
}

DI void sb_item(const P& p, int item, bf16_t* vT  , int lane) {
    const int r = lane & 31, hh = lane >> 5;
    const int qt = 131 - (item >> 6), bh = item & 63, b = bh >> 3, h = bh & 7;
    const bf16_t* base = (const bf16_t*)(p.ws + WS_R1) + (size_t)b * TT * N0;
    const int q0 = 32 * qt, qpos = q0 + r;
    bf16x8 qf[4];
#pragma unroll
    for (int s = 0; s < 4; ++s) qf[s] = *(const bf16x8*)(base + (size_t)(q0 + r) * N0 + 2048 + h * 64 + 16 * s + 8 * hh);
    f32x16 o[2];
#pragma unroll
    for (int j = 0; j < 16; ++j) { o[0][j] = 0.f; o[1][j] = 0.f; }
    float R = 0.f;
#pragma unroll 1
    for (int kt = qt; kt >= 3; --kt) {
        const int k0 = 32 * kt;
        f32x16 z;
#pragma unroll
        for (int j = 0; j < 16; ++j) z[j] = 0.f;
#pragma unroll
        for (int s = 0; s < 4; ++s) z = MFMA32(*(const bf16x8*)(base + (size_t)(k0 + r) * N0 + 2560 + h * 64 + 16 * s + 8 * hh), qf[s], z);
#pragma unroll
        for (int i = 0; i < 4; ++i) {
            const int c = i * 64 + lane, key = c >> 3, d0 = (c & 7) * 8;
            const u32x4 v8 = *(const u32x4*)(base + (size_t)(k0 + key) * N0 + 3072 + h * 64 + d0);
#pragma unroll
            for (int e = 0; e < 8; ++e) vT[(d0 + e) * 36 + key] = (unsigned short)((e & 1) ? (v8[e >> 1] >> 16) : (v8[e >> 1] & 0xffffu));
        }
        float l[16], ls[16], suf[16]; bool al[16];
#pragma unroll
        for (int j = 0; j < 16; ++j) {
            const int key = k0 + crow(j, hh);
            const float zz = z[j] * 0.125f;
            al[j] = (key < qpos) && (key >= PADF);
            const float sp = softplusf_(zz);
            l[j] = al[j] ? -sp : 0.f; ls[j] = zz - sp;
        }
        float G[4], Pg[4], offs[4];
#pragma unroll
        for (int g = 0; g < 4; ++g) {
            suf[4 * g + 3] = 0.f; suf[4 * g + 2] = l[4 * g + 3]; suf[4 * g + 1] = suf[4 * g + 2] + l[4 * g + 2]; suf[4 * g] = suf[4 * g + 1] + l[4 * g + 1];
            G[g] = suf[4 * g] + l[4 * g];
            Pg[g] = __shfl_xor(G[g], 32);
        }
        float tail = 0.f;
#pragma unroll
        for (int g = 3; g >= 0; --g) { offs[g] = tail + (hh == 0 ? Pg[g] : 0.f); tail += G[g] + Pg[g]; }
        f32x16 pw;
#pragma unroll
        for (int j = 0; j < 16; ++j) pw[j] = al[j] ? __expf(ls[j] + R + offs[j >> 2] + suf[j]) : 0.f;
        R += tail;
        const bf16x8 pb0 = pack8(pw, 0), pb1 = pack8(pw, 1);
#pragma unroll
        for (int mt = 0; mt < 2; ++mt) {
            o[mt] = MFMA32(loadA(vT + (32 * mt + r) * 36 + 4 * hh), pb0, o[mt]);
            o[mt] = MFMA32(loadA(vT + (32 * mt + r) * 36 + 16 + 4 * hh), pb1, o[mt]);
        }
        if (__ballot(R > -105.f) == 0ull) break;
    }
    bf16_t* op = (bf16_t*)(p.ws + WS_MIX) + ((size_t)b * TT + q0 + r) * DM + 512 + h * 64 + 4 * hh;
#pragma unroll
    for (int mt = 0; mt < 2; ++mt)
#pragma unroll
        for (int g = 0; g < 4; ++g) {
            u32x2 w = {pack2(o[mt][4 * g], o[mt][4 * g + 1]), pack2(o[mt][4 * g + 2], o[mt][4 * g + 3])};
            *(u32x2*)(op + 32 * mt + 8 * g) = w;
        }
}

constexpr int NPHASE = 17;
#ifndef KSEL
#define KSEL 0x1ff
#endif
#define KON(k) (((KSEL) >> (k)) & 1)
__global__ __launch_bounds__(512) void mega(P p) {
    extern __shared__ __attribute__((aligned(16))) unsigned char shm[];
    cg::grid_group grid = cg::this_grid();
    bf16_t* h16 = (bf16_t*)(p.ws + WS_H16); bf16_t* r1 = (bf16_t*)(p.ws + WS_R1); bf16_t* mix = (bf16_t*)(p.ws + WS_MIX);
    float* side = (float*)(p.ws + WS_SIDE);
    unsigned* ctl = (unsigned*)(p.ws + WS_CTL);
#pragma unroll 1
    for (int ph = p.ph_lo; ph < p.ph_hi; ++ph) {
        int kind = 0;
        pg8::Gemm g{}; bf16_t* O = nullptr; int ldc = 0, act = 0; const float* lg = nullptr; const float* lb = nullptr; int fin = 0;
        switch (ph) {
            case 0: kind = 4; break;
            case 1: kind = 1; g.A = h16; g.Bt = (const bf16_t*)(p.ws + WS_WAB); g.M = MROWS; g.N = N0; g.K = 1024; O = r1; ldc = N0; break;
            case 2: kind = 5; break;
            case 3: kind = 6; break;
            case 4: kind = 2; g.A = mix; g.Bt = (const bf16_t*)(p.ws + WS_WABO); g.M = MROWS; g.N = 1024; g.K = 1024; break;
            case 5: kind = 3; lg = p.in[12]; lb = p.in[13]; break;
            case 6: kind = 1; g.A = h16; g.Bt = (const bf16_t*)(p.ws + WS_W1); g.M = MROWS; g.N = 4096; g.K = 1024; O = r1; ldc = 4096; act = 1; break;
            case 7: kind = 2; g.A = r1; g.Bt = (const bf16_t*)(p.ws + WS_W2); g.M = MROWS; g.N = 1024; g.K = 4096; break;
            case 8: kind = 3; lg = p.in[16]; lb = p.in[17]; break;
            case 9: kind = 1; g.A = h16; g.Bt = (const bf16_t*)(p.ws + WS_WC); g.M = MROWS; g.N = N1; g.K = 1024; O = r1; ldc = N1; break;
            case 10: kind = 7; break;
            case 11: kind = 8; break;
            case 12: kind = 2; g.A = mix; g.Bt = (const bf16_t*)(p.ws + WS_WCO); g.M = MROWS; g.N = 1024; g.K = 1024; break;
            case 13: kind = 3; lg = p.in[12] + 1024; lb = p.in[13] + 1024; break;
            case 14: kind = 1; g.A = h16; g.Bt = (const bf16_t*)(p.ws + WS_W1) + (size_t)4096 * 1024; g.M = MROWS; g.N = 4096; g.K = 1024; O = r1; ldc = 4096; act = 1; break;
            case 15: kind = 2; g.A = r1; g.Bt = (const bf16_t*)(p.ws + WS_W2) + (size_t)4096 * 1024; g.M = MROWS; g.N = 1024; g.K = 4096; break;
            default: kind = 3; lg = p.in[16] + 1024; lb = p.in[17] + 1024; fin = 1; break;
        }
        if (KON(1) && kind == 1) {
            pg8::StaticOrder S; S.init(g.M, g.N, (int)gridDim.x, (int)blockIdx.x);
            EpiStore E{O, ldc, act};
            pg8::gemm_phase<EpiStore, pg8::StaticOrder, false>((PG8_LAS unsigned char*)shm, g, S, E, nullptr);
        } else if (KON(2) && kind == 2) {
            pg8::StaticOrder S; S.init(g.M, g.N, (int)gridDim.x, (int)blockIdx.x);
            EpiResid E{h16, p.out, side};
            pg8::gemm_phase<EpiResid, pg8::StaticOrder, false>((PG8_LAS unsigned char*)shm, g, S, E, nullptr);
        } else if (KON(3) && kind == 3) {
            ln_phase(p, lg, lb, fin);
        } else if (KON(4) && kind == 4) {
            prep_phase(p, shm);
        } else if (KON(5) && kind == 5) {
            for (int it = blockIdx.x; it < NB * 4 * NCH; it += gridDim.x) gdn_prep_item(p, it, shm);
        } else if (KON(6) && kind == 6) {
            for (int ch = blockIdx.x; ch < NB * 4; ch += gridDim.x) scan_chain<0>(p, ch, shm);
            const int tid = my_tid();
            bf16_t* vT = (bf16_t*)shm + (tid >> 6) * (64 * 36);
            for (;;) {
                int it = 0;
                if ((tid & 63) == 0) it = (int)atomicAdd(ctl, 1u);
                it = __builtin_amdgcn_readfirstlane(it);
                if (it >= SB_ITEMS) break;
                sb_item(p, it, vT, tid & 63);
            }
        } else if (KON(7) && kind == 7) {
            for (int it = blockIdx.x; it < NB * 8 * NCH; it += gridDim.x) hg_prep_item(p, it, shm);
        } else if (KON(8) && kind == 8) {
            for (int ch = blockIdx.x; ch < NB * 8; ch += gridDim.x) scan_chain<1>(p, ch, shm);
        }
        if (ph + 1 < p.ph_hi) grid.sync();
    }
}

extern "C" void kernel_launch(void* const* d_in, const int* in_sizes, int n_in, void* d_out, int out_size, void* d_ws, size_t ws_size, hipStream_t stream) {
    static int grid = 0;
    if (grid == 0) {
        if (n_in != 18 || out_size != NB * SEQ * DM || ws_size < WS_END) { fprintf(stderr, "kernel_launch: unexpected shapes (n_in %d out %d ws %zu need %zu)\n", n_in, out_size, ws_size, (size_t)WS_END); grid = -1; return; }
        int dev = 0, cus = 0, per_cu = 0;
        hipGetDevice(&dev);
        hipDeviceGetAttribute(&cus, hipDeviceAttributeMultiprocessorCount, dev);
        if (hipFuncSetAttribute((const void*)mega, hipFuncAttributeMaxDynamicSharedMemorySize, LDS_BYTES) != hipSuccess) { fprintf(stderr, "kernel_launch: hipFuncSetAttribute failed\n"); grid = -1; return; }
        hipOccupancyMaxActiveBlocksPerMultiprocessor(&per_cu, (const void*)mega, 512, LDS_BYTES);
        if (per_cu < 1) { fprintf(stderr, "kernel_launch: occupancy query says %d blocks per CU\n", per_cu); per_cu = 1; }
        (void)hipGetLastError();
        grid = cus;
    }
    if (grid < 0) return;
    hipMemsetAsync((unsigned char*)d_ws + WS_CTL, 0, 4096, stream);
    P p{};
    for (int i = 0; i < 18; ++i) p.in[i] = (const float*)d_in[i];
    p.out = (float*)d_out; p.ws = (unsigned char*)d_ws;
#ifndef MK_MULTI
    p.ph_lo = 0; p.ph_hi = NPHASE;
    void* args[] = {&p};
    hipError_t e = hipLaunchCooperativeKernel((const void*)mega, dim3(grid), dim3(512), args, LDS_BYTES, stream);
    if (e != hipSuccess) fprintf(stderr, "cooperative launch failed: %s (grid %d)\n", hipGetErrorString(e), grid);
#else
    for (int ph = 0; ph < NPHASE; ++ph) { p.ph_lo = ph; p.ph_hi = ph + 1; hipLaunchKernelGGL(mega, dim3(grid), dim3(512), LDS_BYTES, stream, p); }
#endif
}
```

```cpp
#include <hip/hip_runtime.h>
#include <hip/hip_cooperative_groups.h>
#include <cstdio>
namespace cg = cooperative_groups;
namespace pg8 {
#define PG8_LAS __attribute__((address_space(3)))
typedef unsigned short bf16_t;
typedef short bf16x8 __attribute__((ext_vector_type(8)));
typedef float f32x4 __attribute__((ext_vector_type(4)));
typedef unsigned u32x4 __attribute__((ext_vector_type(4)));
constexpr int BM = 256, BK = 64, HALF = 128, HTB = HALF * BK * 2  , STAGE_BYTES = 8 * HTB, NXCD = 8, WGM = 8;

__host__ __device__ __forceinline__ int lds_byte(int r, int c) { const int st = (r >> 4) * 2 + (c >> 5), rr = r & 15, cc = c & 31, ob = rr * 64 + cc * 2; return st * 1024 + (ob ^ (((ob >> 9) & 1) << 5)); }
__host__ __device__ __forceinline__ void stage_rc(int b, int& R, int& C) { const int st = b / 1024, sb = b % 1024, swz = sb ^ (((sb >> 9) & 1) << 5); R = (st >> 1) * 16 + swz / 64; C = (st & 1) * 32 + (swz % 64) / 2; }
__host__ __device__ __forceinline__ int perm32(int rho) { const int n = rho >> 4, i = rho & 15; return 8 * (i >> 2) + 4 * n + (i & 3); }

struct Unit { int pm, pn, kp; };
struct Gemm { const bf16_t* A; const bf16_t* Bt; int M, N, K, xonly, lda, ldb; };
__host__ __device__ __forceinline__ int rowbase(int pm, int xonly) { return xonly ? (pm >> 4) * 4224 + 128 + (pm & 15) * 256 : pm * 256; }

struct StaticOrder {
    int nM, nN, nwg, G, c;
    __host__ __device__ void init(int M, int N, int G_, int c_) { nM = M / BM; nN = N / BM; nwg = nM * nN; G = G_; c = c_; }
    __host__ __device__ bool next(int i, Unit& u) const {
        const long L = (long)i * G + c; if (L >= nwg) return false;
        int wgid = (int)L; { const int q = nwg / NXCD, r = nwg % NXCD, xcd = wgid % NXCD, off = wgid / NXCD; wgid = (xcd < r ? xcd * (q + 1) : r * (q + 1) + (xcd - r) * q) + off; }
        const int nig = WGM * nN, gid = wgid / nig, fm = gid * WGM, gsz = (nM - fm) < WGM ? (nM - fm) : WGM;
        u.pm = fm + ((wgid % nig) % gsz); u.pn = (wgid % nig) / gsz; u.kp = 0; return true;
    }
    __device__ __forceinline__ void a_ready(const Unit&) const {}
    __device__ __forceinline__ void done(const Unit&) const {}
};
struct TailOrder {
    int npieces, nk, pm0, G, c;
    __device__ __forceinline__ bool next(int i, Unit& u) const { const int L = i * G + c; if (L >= npieces) return false; const int tile = L / nk; u.kp = L - tile * nk; u.pm = pm0 + (tile >> 2); u.pn = tile & 3; return true; }
    __device__ __forceinline__ void a_ready(const Unit&) const {}
    __device__ __forceinline__ void done(const Unit&) const {}
};
template <class Epi, class Sched, bool STAMP = false>
__device__ __forceinline__ void gemm_phase(PG8_LAS unsigned char* lds, const Gemm g, const Sched& S, const Epi& E, unsigned long long* stamps) {
    int tid_ = threadIdx.x; asm volatile("" : "+v"(tid_)); const int tid = tid_, wid = __builtin_amdgcn_readfirstlane(tid >> 6), lane = tid & 63, wr = wid >> 2, wc = wid & 3, fr = lane & 15, fq = lane >> 4;
    const int K = g.K, nt = K / BK;
    int ts_lo = 0, ts_hi = 0, nts = 0; const unsigned long long rt_entry = STAMP ? (unsigned long long)wall_clock64() : 0ull;
#define PG8_STAMP() do { if (STAMP && wid == 0 && nts < 64) { const unsigned long long _c = (unsigned long long)clock64(); \
        ts_lo = (lane == nts) ? (int)(unsigned)_c : ts_lo; ts_hi = (lane == nts) ? (int)(unsigned)(_c >> 32) : ts_hi; ++nts; } } while (0)
    PG8_STAMP();
    unsigned voffA[2], voffB[2];
#pragma unroll
    for (int i = 0; i < 2; ++i) { int R, C; stage_rc(tid * 16 + i * 8192, R, C); const int Rb = Epi::PERM ? ((R & ~31) + perm32(R & 31)) : R;
        voffA[i] = (unsigned)(R * g.lda + C) * 2u; voffB[i] = (unsigned)(Rb * g.ldb + C) * 2u; }
    const size_t kstep = (size_t)(BK * 2);
    const size_t hstep = (size_t)HALF * g.ldb * 2;
    const size_t tstep = 2 * hstep;
    const size_t hstepA = (size_t)HALF * g.lda * 2;
    const unsigned ldsw = (unsigned)wid * 1024u;
    const int aoff = lds_byte(wr * 64 + fr, fq * 8), boff = lds_byte(wc * 32 + fr, fq * 8);
#define PG8_SA(b, h) (((b) * 2 + (h)) * HTB)
#define PG8_SB(b, h) ((4 + (b) * 2 + (h)) * HTB)
#define PG8_STAGE(bufoff, gbase, voff) do { _Pragma("unroll") for (int _i = 0; _i < 2; ++_i) \
        __builtin_amdgcn_global_load_lds((const unsigned*)((const char*)(gbase) + (voff)[_i]), (PG8_LAS unsigned*)(lds + (bufoff) + ldsw + _i * 8192), 16, 0, 0); } while (0)
#define PG8_LDA(dst, b, h) do { _Pragma("unroll") for (int m = 0; m < 4; ++m) _Pragma("unroll") for (int k = 0; k < 2; ++k) dst[m][k] = *(const PG8_LAS bf16x8*)(lds + PG8_SA(b, h) + aoff + m * 2048 + k * 1024); } while (0)
#define PG8_LDB(dst, b, h) do { _Pragma("unroll") for (int n = 0; n < 2; ++n) _Pragma("unroll") for (int k = 0; k < 2; ++k) dst[n][k] = *(const PG8_LAS bf16x8*)(lds + PG8_SB(b, h) + boff + n * 2048 + k * 1024); } while (0)
#define PG8_MMA(ai, bj, At, Bt) do { __builtin_amdgcn_s_setprio(1); _Pragma("unroll") for (int m = 0; m < 4; ++m) _Pragma("unroll") for (int n = 0; n < 2; ++n) _Pragma("unroll") for (int k = 0; k < 2; ++k) \
        acc[ai][bj][m][n] = __builtin_amdgcn_mfma_f32_16x16x32_bf16(Bt[n][k], At[m][k], acc[ai][bj][m][n], 0, 0, 0); __builtin_amdgcn_s_setprio(0); } while (0)
#define PG8_WAIT_V(n) asm volatile("s_waitcnt vmcnt(" #n ")" ::: "memory")
#define PG8_WAIT_L(n) asm volatile("s_waitcnt lgkmcnt(" #n ")" ::: "memory")
#define PG8_BAR __builtin_amdgcn_s_barrier()
#define PG8_SCHED __builtin_amdgcn_sched_barrier(0)
    Unit cur, nxt; int ui = 0;
    if (!S.next(0, cur)) return;
    f32x4 acc[2][2][4][2];
#pragma unroll
    for (int a = 0; a < 2; ++a)
#pragma unroll
        for (int b = 0; b < 2; ++b)
#pragma unroll
            for (int m = 0; m < 4; ++m)
#pragma unroll
                for (int n = 0; n < 2; ++n) acc[a][b][m][n] = (f32x4){0.f, 0.f, 0.f, 0.f};
    bf16x8 At[4][2], B0[2][2], B1[2][2];
    const size_t rstep = (size_t)g.lda * 2;
    const char* cA = (const char*)g.A + (size_t)rowbase(cur.pm, g.xonly) * rstep + (size_t)cur.kp * K * 2; const char* cB = (const char*)g.Bt + (size_t)cur.pn * tstep + (size_t)cur.kp * K * 2;
    S.a_ready(cur);
    PG8_STAGE(PG8_SB(0, 0), cB, voffB); PG8_STAGE(PG8_SA(0, 0), cA, voffA); PG8_STAGE(PG8_SB(0, 1), cB + hstep, voffB); PG8_STAGE(PG8_SA(0, 1), cA + hstepA, voffA);
    if (wr == 1) PG8_BAR;
    PG8_WAIT_V(4); PG8_BAR;
    PG8_STAGE(PG8_SB(1, 0), cB + kstep, voffB); PG8_STAGE(PG8_SA(1, 0), cA + kstep, voffA); PG8_STAGE(PG8_SB(1, 1), cB + hstep + kstep, voffB);
    PG8_WAIT_V(6); PG8_BAR;
    PG8_STAMP();
    for (;;) {
        const bool has_next = S.next(ui + 1, nxt);
        const char* nA = has_next ? (const char*)g.A + (size_t)rowbase(nxt.pm, g.xonly) * rstep + (size_t)nxt.kp * K * 2 : cA; const char* nB = has_next ? (const char*)g.Bt + (size_t)nxt.pn * tstep + (size_t)nxt.kp * K * 2 : cB;
        for (int t = 0; t < nt; t += 2) {
            const bool last = (t == nt - 2);
            const char* a1 = cA + (size_t)(t + 1) * kstep;
            const char* a2 = last ? nA : cA + (size_t)(t + 2) * kstep; const char* b2 = last ? nB : cB + (size_t)(t + 2) * kstep;
            const char* a3 = a2 + kstep; const char* b3 = b2 + kstep;
            if (last && has_next) S.a_ready(nxt);
            PG8_LDB(B0, 0, 0); PG8_SCHED; PG8_LDA(At, 0, 0); PG8_STAGE(PG8_SA(1, 1), a1 + hstepA, voffA);
            PG8_WAIT_L(8); PG8_BAR; PG8_WAIT_L(0); PG8_MMA(0, 0, At, B0); PG8_BAR; PG8_SCHED;
            PG8_LDB(B1, 0, 1); PG8_STAGE(PG8_SB(0, 0), b2, voffB);
            PG8_BAR; PG8_WAIT_L(0); PG8_MMA(0, 1, At, B1); PG8_BAR;
            PG8_LDA(At, 0, 1); PG8_STAGE(PG8_SA(0, 0), a2, voffA);
            PG8_BAR; PG8_WAIT_L(0); PG8_MMA(1, 0, At, B0); PG8_BAR; PG8_SCHED;
            PG8_STAGE(PG8_SB(0, 1), b2 + hstep, voffB);
            PG8_WAIT_V(6); PG8_BAR; PG8_MMA(1, 1, At, B1); PG8_BAR;
            PG8_LDB(B0, 1, 0); PG8_SCHED; PG8_LDA(At, 1, 0); PG8_STAGE(PG8_SA(0, 1), a2 + hstepA, voffA);
            PG8_WAIT_L(8); PG8_BAR; PG8_WAIT_L(0); PG8_MMA(0, 0, At, B0); PG8_BAR; PG8_SCHED;
            PG8_LDB(B1, 1, 1); PG8_STAGE(PG8_SB(1, 0), b3, voffB);
            PG8_BAR; PG8_WAIT_L(0); PG8_MMA(0, 1, At, B1); PG8_BAR;
            PG8_LDA(At, 1, 1); PG8_STAGE(PG8_SA(1, 0), a3, voffA);
            PG8_BAR; PG8_WAIT_L(0); PG8_MMA(1, 0, At, B0); PG8_BAR; PG8_SCHED;
            PG8_STAGE(PG8_SB(1, 1), b3 + hstep, voffB);
            PG8_WAIT_V(6); PG8_BAR; PG8_MMA(1, 1, At, B1); PG8_BAR;
        }
        PG8_STAMP();
        if constexpr (!Epi::AFTER_DRAIN) { E(acc, cur, wr, wc, fr, fq); S.done(cur); }
        PG8_STAMP();
        if (!has_next) break;
#pragma unroll
        for (int a = 0; a < 2; ++a)
#pragma unroll
            for (int b = 0; b < 2; ++b)
#pragma unroll
                for (int m = 0; m < 4; ++m)
#pragma unroll
                    for (int n = 0; n < 2; ++n) acc[a][b][m][n] = (f32x4){0.f, 0.f, 0.f, 0.f};
        cur = nxt; cA = nA; cB = nB; ++ui;
    }
    PG8_WAIT_V(0);
    if (wr == 0) PG8_BAR;
    PG8_BAR;
    if constexpr (Epi::AFTER_DRAIN) { E.fused(acc, cur, wr, wc, fr, fq, lds, wid, lane); S.done(cur); }
    PG8_STAMP();
    if (STAMP && wid == 0) { stamps[lane] = lane < nts ? (((unsigned long long)(unsigned)ts_hi << 32) | (unsigned)ts_lo) : 0ull;
        if (lane == 62) stamps[62] = rt_entry; if (lane == 63) stamps[63] = (unsigned long long)wall_clock64(); }
#undef PG8_STAMP
#undef PG8_SA
#undef PG8_SB
#undef PG8_STAGE
#undef PG8_LDA
#undef PG8_LDB
#undef PG8_MMA
#undef PG8_WAIT_V
#undef PG8_WAIT_L
#undef PG8_BAR
#undef PG8_SCHED
}
}

using pg8::bf16_t; using pg8::bf16x8; using pg8::f32x4; using pg8::u32x4;
typedef float f32x16 __attribute__((ext_vector_type(16)));
typedef float f32x2v __attribute__((ext_vector_type(2)));
typedef __bf16 bf2v __attribute__((ext_vector_type(2)));
typedef unsigned u32x2 __attribute__((ext_vector_type(2)));
#define DI __device__ __forceinline__
#define MFMA32(a, b, c) __builtin_amdgcn_mfma_f32_32x32x16_bf16((a), (b), (c), 0, 0, 0)

constexpr int NB = 8, SEQ = 4096, PADF = 112, XOFF = 128, TT = 4224, MROWS = NB * TT, DM = 1024, DFF = 4096;
constexpr int N0 = 3840, N1 = 4096, LD1 = 4160, NCH = TT / 64;
constexpr float DN_ALPHA = 1.4142135623730951f;
constexpr int LDS_BYTES = 153600;
constexpr int SB_ITEMS = 129 * 64;
constexpr int TAIL0 = 32768;

constexpr size_t WS_CTL = 0;
constexpr size_t WS_WAB = 16384;
constexpr size_t WS_WABO = WS_WAB + (size_t)N0 * 1024 * 2;
constexpr size_t WS_WC = WS_WABO + (size_t)1024 * 1024 * 2;
constexpr size_t WS_WCO = WS_WC + (size_t)4096 * 1024 * 2;
constexpr size_t WS_W1 = WS_WCO + (size_t)1024 * 1024 * 2;
constexpr size_t WS_W2 = WS_W1 + (size_t)2 * 4096 * 1024 * 2;
constexpr size_t WS_H16 = WS_W2 + (size_t)2 * 4096 * 1024 * 2;
constexpr size_t WS_R1 = WS_H16 + (size_t)MROWS * 1024 * 2;
constexpr size_t WS_MIX = WS_R1 + (size_t)MROWS * LD1 * 2;
constexpr size_t WS_SIDE = WS_MIX + (size_t)MROWS * 1024 * 2;
constexpr size_t WS_KDT = WS_SIDE + (size_t)NB * 128 * 1024 * 4;
constexpr size_t WS_GA = WS_KDT + (size_t)MROWS * 512 * 2;
constexpr size_t WS_GT = WS_GA + (size_t)MROWS * 256 * 2;
constexpr size_t WS_END = WS_GT + 16384;
constexpr size_t DO_W = 0, DO_QD = (size_t)MROWS * 512 * 2, DO_UT = 2 * DO_QD;
constexpr size_t DO_HA = 0, DO_DVEC = (size_t)NB * 8 * NCH * 4096 * 2;

struct P { const float* in[18]; float* out; unsigned char* ws; int ph_lo, ph_hi; };

DI int my_tid() { int t = threadIdx.x; asm volatile("" : "+v"(t)); return t; }
DI float bf2f(unsigned short b) { return __uint_as_float(((unsigned)b) << 16); }
DI unsigned pack2(float lo, float hi) { f32x2v v = {lo, hi}; bf2v b = __builtin_convertvector(v, bf2v); return __builtin_bit_cast(unsigned, b); }
DI unsigned short f2bf(float x) { return (unsigned short)(pack2(x, 0.f) & 0xffffu); }
DI int crow(int reg, int h) { return (reg & 3) + 8 * (reg >> 2) + 4 * h; }
DI float sigmoidf_(float x) { return __builtin_amdgcn_rcpf(1.f + __expf(-x)); }
DI float siluf_(float x) { return x * __builtin_amdgcn_rcpf(1.f + __expf(-x)); }
DI float softplusf_(float x) { return fmaxf(x, 0.f) + __logf(1.f + __expf(-fabsf(x))); }
DI float lo16(unsigned u) { return __uint_as_float(u << 16); }
DI float hi16(unsigned u) { return __uint_as_float(u & 0xffff0000u); }
DI bf16x8 pack8(const f32x16& x, int s) {
    u32x4 p;
    p[0] = pack2(x[8 * s + 0], x[8 * s + 1]); p[1] = pack2(x[8 * s + 2], x[8 * s + 3]);
    p[2] = pack2(x[8 * s + 4], x[8 * s + 5]); p[3] = pack2(x[8 * s + 6], x[8 * s + 7]);
    return __builtin_bit_cast(bf16x8, p);
}
DI bf16x8 loadA(const bf16_t* p) {
    u32x2 a = *(const u32x2*)p, b = *(const u32x2*)(p + 8);
    u32x4 v = {a[0], a[1], b[0], b[1]};
    return __builtin_bit_cast(bf16x8, v);
}
DI float* yrow(float* dout, float* side, int row) {
    const int b = row / TT, pos = row - b * TT;
    return pos >= XOFF ? dout + ((size_t)b * SEQ + (pos - XOFF)) * DM : side + ((size_t)b * XOFF + pos) * DM;
}

struct EpiStore {
    static constexpr bool PERM = true, AFTER_DRAIN = false;
    bf16_t* O; int ldc; int act; int xonly; int sl, sh;
    DI void operator()(const f32x4 (&acc)[2][2][4][2], const pg8::Unit& u, int wr, int wc, int fr, int fq) const {
        const int row0 = pg8::rowbase(u.pm, xonly) + wr * 64 + fr, col0 = u.pn * 256 + wc * 32 + 8 * fq;
        const bool gate = u.pn >= sl && u.pn < sh;
#pragma unroll
        for (int ai = 0; ai < 2; ++ai)
#pragma unroll
            for (int m = 0; m < 4; ++m) {
                bf16_t* rowp = O + (size_t)(row0 + ai * 128 + m * 16) * ldc + col0;
#pragma unroll
                for (int bj = 0; bj < 2; ++bj) {
                    f32x4 v0 = acc[ai][bj][m][0], v1 = acc[ai][bj][m][1];
                    if (act) {
#pragma unroll
                        for (int e = 0; e < 4; ++e) { float a = fmaxf(v0[e], 0.f), b = fmaxf(v1[e], 0.f); v0[e] = a * a; v1[e] = b * b; }
                    }
                    if (gate) {
#pragma unroll
                        for (int e = 0; e < 4; ++e) { v0[e] = siluf_(v0[e]); v1[e] = siluf_(v1[e]); }
                    }
                    u32x4 o = {pack2(v0[0], v0[1]), pack2(v0[2], v0[3]), pack2(v1[0], v1[1]), pack2(v1[2], v1[3])};
                    __builtin_nontemporal_store(o, (u32x4*)(rowp + bj * 128));
                }
            }
    }
};
struct EpiResid {
    static constexpr bool PERM = true, AFTER_DRAIN = false;
    const bf16_t* H; bf16_t* Y; int xonly;
    DI void operator()(const f32x4 (&acc)[2][2][4][2], const pg8::Unit& u, int wr, int wc, int fr, int fq) const {
        const int row0 = pg8::rowbase(u.pm, xonly) + wr * 64 + fr, col0 = u.pn * 256 + wc * 32 + 8 * fq;
#pragma unroll
        for (int ai = 0; ai < 2; ++ai)
#pragma unroll
            for (int m = 0; m < 4; ++m) {
                const size_t ro = (size_t)(row0 + ai * 128 + m * 16) * DM + col0;
#pragma unroll
                for (int bj = 0; bj < 2; ++bj) {
                    const u32x4 hv = *(const u32x4*)(H + ro + bj * 128);
                    const f32x4 v0 = acc[ai][bj][m][0], v1 = acc[ai][bj][m][1];
                    u32x4 o = {pack2(DN_ALPHA * lo16(hv[0]) + v0[0], DN_ALPHA * hi16(hv[0]) + v0[1]), pack2(DN_ALPHA * lo16(hv[1]) + v0[2], DN_ALPHA * hi16(hv[1]) + v0[3]),
                               pack2(DN_ALPHA * lo16(hv[2]) + v1[0], DN_ALPHA * hi16(hv[2]) + v1[1]), pack2(DN_ALPHA * lo16(hv[3]) + v1[2], DN_ALPHA * hi16(hv[3]) + v1[3])};
                    *(u32x4*)(Y + ro + bj * 128) = o;
                }
            }
    }
};

struct EpiPart {
    static constexpr bool PERM = false, AFTER_DRAIN = false;
    float* slab; int row_origin;
    DI void operator()(const f32x4 (&acc)[2][2][4][2], const pg8::Unit& u, int wr, int wc, int fr, int fq) const {
        const int row0 = u.pm * 256 - row_origin + wr * 64 + fr, col0 = u.pn * 256 + wc * 32 + 4 * fq;
#pragma unroll
        for (int ai = 0; ai < 2; ++ai)
#pragma unroll
            for (int m = 0; m < 4; ++m) {
                float* rp = slab + ((size_t)u.kp * 1024 + (row0 + ai * 128 + m * 16)) * 1024 + col0;
#pragma unroll
                for (int bj = 0; bj < 2; ++bj)
#pragma unroll
                    for (int n = 0; n < 2; ++n) *(f32x4*)(rp + bj * 128 + n * 16) = acc[ai][bj][m][n];
            }
    }
};

DI void prep_phase(const P& p, unsigned char* lds, int part, int wid, int nwk) {
    float* tile = (float*)lds;
    const int tid = my_tid();
    constexpr int NT0 = 16 * 60, NT1 = 16 * 16, NT2 = 16 * 64, NT3 = 16 * 16, NT4 = 16 * 64, NT5 = 64 * 16;
    constexpr int C0 = NT0, C1 = C0 + NT1, C2 = C1 + NT2, C3 = C2 + NT3, C4 = C3 + 2 * NT4, C5 = C4 + 2 * NT5;
    const int npart = part == 0 ? C0 : (part == 1 ? (C2 - C0) + NT4 + NT5 : (C3 - C2) + NT4 + NT5);
    for (int j = wid; j < npart; j += nwk) {
        int tix;
        if (part == 0) tix = j;
        else if (part == 1) tix = j < (C2 - C0) ? C0 + j : (j < (C2 - C0) + NT4 ? C3 + (j - (C2 - C0)) : C4 + (j - (C2 - C0) - NT4));
        else tix = j < (C3 - C2) ? C2 + j : (j < (C3 - C2) + NT4 ? C3 + NT4 + (j - (C3 - C2)) : C4 + NT5 + (j - (C3 - C2) - NT4));
        const float* src; bf16_t* dst; int K, Ns, Nd, loc, remap = 0;
        if (tix < C0) { src = p.in[2]; dst = (bf16_t*)(p.ws + WS_WAB); K = 1024; Ns = 3592; Nd = N0; loc = tix; remap = 1; }
        else if (tix < C1) { src = p.in[7]; dst = (bf16_t*)(p.ws + WS_WABO); K = 1024; Ns = 1024; Nd = 1024; loc = tix - C0; }
        else if (tix < C2) { src = p.in[8]; dst = (bf16_t*)(p.ws + WS_WC); K = 1024; Ns = 4096; Nd = 4096; loc = tix - C1; }
        else if (tix < C3) { src = p.in[11]; dst = (bf16_t*)(p.ws + WS_WCO); K = 1024; Ns = 1024; Nd = 1024; loc = tix - C2; }
        else if (tix < C4) { int l = (tix - C3) / NT4; src = p.in[14] + (size_t)l * 1024 * 4096; dst = (bf16_t*)(p.ws + WS_W1) + (size_t)l * 4096 * 1024; K = 1024; Ns = 4096; Nd = 4096; loc = (tix - C3) % NT4; }
        else { int l = (tix - C4) / NT5; src = p.in[15] + (size_t)l * 4096 * 1024; dst = (bf16_t*)(p.ws + WS_W2) + (size_t)l * 1024 * 4096; K = 4096; Ns = 1024; Nd = 1024; loc = (tix - C4) % NT5; }
        const int ntn = Nd / 64, kt = loc / ntn, nt = loc % ntn, k0 = kt * 64, n0 = nt * 64;
#pragma unroll
        for (int it = 0; it < 2; ++it) {
            const int i = (tid >> 4) + 32 * it, j = (tid & 15) * 4, n = n0 + j;
            int ns = n; bool valid = true;
            if (remap) { if (n < 2048) ns = n; else if (n < 3584) ns = n + 8; else if (n < 3592) ns = n - 3584 + 2048; else valid = false; }
            f32x4 v = {0.f, 0.f, 0.f, 0.f};
            if (valid) v = *(const f32x4*)(src + (size_t)(k0 + i) * Ns + ns);
            tile[i * 65 + j] = v[0]; tile[i * 65 + j + 1] = v[1]; tile[i * 65 + j + 2] = v[2]; tile[i * 65 + j + 3] = v[3];
        }
        __syncthreads();
        {
            const int j = tid >> 3, i0 = (tid & 7) * 8;
            u32x4 o;
#pragma unroll
            for (int e = 0; e < 4; ++e) o[e] = pack2(tile[(i0 + 2 * e) * 65 + j], tile[(i0 + 2 * e + 1) * 65 + j]);
            *(u32x4*)(dst + (size_t)(n0 + j) * K + k0 + i0) = o;
        }
        __syncthreads();
    }
    if (part != 0) return;
    bf16_t* h16 = (bf16_t*)(p.ws + WS_H16);
    const float* x = p.in[0]; const float* meta = p.in[1];
    for (int uidx = blockIdx.x * 512 + tid; uidx < MROWS * 128; uidx += gridDim.x * 512) {
        const int row = uidx >> 7, c0 = (uidx & 127) * 8, b = row / TT, pos = row - b * TT;
        u32x4 o = {0u, 0u, 0u, 0u};
        if (pos >= PADF) {
            const float* s = pos >= XOFF ? x + ((size_t)b * SEQ + (pos - XOFF)) * DM + c0 : meta + (size_t)(pos - PADF) * DM + c0;
            const f32x4 a = *(const f32x4*)s, c = *(const f32x4*)(s + 4);
            o[0] = pack2(a[0], a[1]); o[1] = pack2(a[2], a[3]); o[2] = pack2(c[0], c[1]); o[3] = pack2(c[2], c[3]);
        }
        *(u32x4*)(h16 + (size_t)row * DM + c0) = o;
    }
}

DI float wave_sum(float v) {
#pragma unroll
    for (int o = 32; o >= 1; o >>= 1) v += __shfl_xor(v, o);
    return v;
}
DI void ln_phase(const P& p, const bf16_t* Y, const float* g, const float* bb, int xonly, int final_, int nk) {
    const int tid = my_tid(), lane = tid & 63, gw = blockIdx.x * 8 + (tid >> 6), nw = gridDim.x * 8;
    bf16_t* h16 = (bf16_t*)(p.ws + WS_H16);
    f32x4 gv[4], bv[4];
#pragma unroll
    for (int i = 0; i < 2; ++i) { gv[2 * i] = *(const f32x4*)(g + i * 512 + lane * 8); gv[2 * i + 1] = *(const f32x4*)(g + i * 512 + lane * 8 + 4);
                                  bv[2 * i] = *(const f32x4*)(bb + i * 512 + lane * 8); bv[2 * i + 1] = *(const f32x4*)(bb + i * 512 + lane * 8 + 4); }
    for (int row = gw; row < MROWS; row += nw) {
        const int b = row / TT, pos = row - b * TT;
        if (xonly && pos < XOFF) continue;
        const bf16_t* y = Y + (size_t)row * DM;
        float v[16]; float s = 0.f;
        if (nk > 0 && row >= TAIL0) {
#pragma unroll
            for (int i = 0; i < 2; ++i) {
                const u32x4 w = *(const u32x4*)(h16 + (size_t)row * DM + i * 512 + lane * 8);
#pragma unroll
                for (int e = 0; e < 4; ++e) { v[8 * i + 2 * e] = DN_ALPHA * lo16(w[e]); v[8 * i + 2 * e + 1] = DN_ALPHA * hi16(w[e]); }
            }
            for (int kp = 0; kp < nk; ++kp) {
                const float* sp = p.out + ((size_t)kp * 1024 + (row - TAIL0)) * 1024 + lane * 8;
#pragma unroll
                for (int i = 0; i < 2; ++i) {
                    const f32x4 a = *(const f32x4*)(sp + i * 512), c = *(const f32x4*)(sp + i * 512 + 4);
#pragma unroll
                    for (int e = 0; e < 4; ++e) { v[8 * i + e] += a[e]; v[8 * i + 4 + e] += c[e]; }
                }
            }
        } else {
#pragma unroll
            for (int i = 0; i < 2; ++i) {
                const u32x4 w = *(const u32x4*)(y + i * 512 + lane * 8);
#pragma unroll
                for (int e = 0; e < 4; ++e) { v[8 * i + 2 * e] = lo16(w[e]); v[8 * i + 2 * e + 1] = hi16(w[e]); }
            }
        }
#pragma unroll
        for (int e = 0; e < 16; ++e) s += v[e];
        const float mean = wave_sum(s) * (1.f / 1024.f);
        float q = 0.f;
#pragma unroll
        for (int e = 0; e < 16; ++e) { const float d = v[e] - mean; q += d * d; }
        const float rstd = rsqrtf(wave_sum(q) * (1.f / 1024.f) + 1e-5f);
        float o[16];
#pragma unroll
        for (int e = 0; e < 16; ++e) o[e] = (v[e] - mean) * rstd * gv[e >> 2][e & 3] + bv[e >> 2][e & 3];
        if (final_) {
            float* dst = p.out + ((size_t)b * SEQ + (pos - XOFF)) * DM;
#pragma unroll
            for (int i = 0; i < 2; ++i) { *(f32x4*)(dst + i * 512 + lane * 8) = (f32x4){o[8 * i], o[8 * i + 1], o[8 * i + 2], o[8 * i + 3]};
                                          *(f32x4*)(dst + i * 512 + lane * 8 + 4) = (f32x4){o[8 * i + 4], o[8 * i + 5], o[8 * i + 6], o[8 * i + 7]}; }
        } else {
#pragma unroll
            for (int i = 0; i < 2; ++i) {
                u32x4 w = {pack2(o[8 * i], o[8 * i + 1]), pack2(o[8 * i + 2], o[8 * i + 3]), pack2(o[8 * i + 4], o[8 * i + 5]), pack2(o[8 * i + 6], o[8 * i + 7])};
                if (pos < PADF) w = (u32x4){0u, 0u, 0u, 0u};
                *(u32x4*)(h16 + (size_t)row * DM + i * 512 + lane * 8) = w;
            }
        }
    }
}

DI void gdn_prep_item(const P& p, int item, unsigned char* lds) {
#ifdef PROBE3
    unsigned long long p3t = __builtin_amdgcn_s_memrealtime(), p3acc = 0ull;
#endif
    const int tid = my_tid(), lane = tid & 63, wv = tid >> 6, r = lane & 31, hh = lane >> 5;
    const int n = item % NCH, hb = item / NCH, h = hb & 3, b = hb >> 2;
    const int row0 = b * TT + n * 64;
    const bf16_t* proj = (const bf16_t*)(p.ws + WS_R1);
    bf16_t* qs = (bf16_t*)lds;
    bf16_t* ks = qs + 64 * 136;
    bf16_t* vbT = ks + 64 * 136;
    bf16_t* kbT = vbT + 128 * 72;
    bf16_t* kdTs = kbT + 128 * 72;
    bf16_t* Tm = kdTs + 128 * 72;
    float* Mm = (float*)(Tm + 64 * 72);
    float* gcs = Mm + 64 * 64; float* betas = gcs + 64;
    float* fac = (float*)(lds + 137216);
    bf16_t* Wg = (bf16_t*)((unsigned char*)p.out + DO_W); bf16_t* QD = (bf16_t*)((unsigned char*)p.out + DO_QD); bf16_t* UT = (bf16_t*)((unsigned char*)p.out + DO_UT);
    bf16_t* KDT = (bf16_t*)(p.ws + WS_KDT); bf16_t* GA = (bf16_t*)(p.ws + WS_GA); float* GT = (float*)(p.ws + WS_GT);
    const float* conv_w = p.in[3];
    bf16_t* vs = Tm;
    {
        const int seg = tid / 48, g48 = tid - seg * 48, part = g48 >> 4, c0 = (g48 & 15) * 8;
        const int ch = part * 512 + h * 128 + c0, pos0 = n * 64 + seg * 8;
        if (tid < 384) {
            u32x4 xr[11]; f32x4 wg[8];
#pragma unroll
            for (int j = 0; j < 11; ++j) {
                const int pp = pos0 - 3 + j;
                xr[j] = (u32x4){0u, 0u, 0u, 0u};
                if (pp >= 0) xr[j] = *(const u32x4*)(proj + (size_t)(b * TT + pp) * N0 + ch);
            }
#pragma unroll
            for (int k = 0; k < 4; ++k) { wg[2 * k] = *(const f32x4*)(conv_w + k * 1536 + ch); wg[2 * k + 1] = *(const f32x4*)(conv_w + k * 1536 + ch + 4); }
            bf16_t* dst = (part == 0 ? qs : (part == 1 ? ks : vs)) + c0;
#pragma unroll
            for (int tt = 0; tt < 8; ++tt) {
                float acc[8];
#pragma unroll
                for (int e = 0; e < 8; ++e) acc[e] = 0.f;
#pragma unroll
                for (int k = 0; k < 4; ++k) {
                    const u32x4 xv = xr[tt + k]; const f32x4 w0 = wg[2 * k], w1 = wg[2 * k + 1];
                    acc[0] += w0[0] * lo16(xv[0]); acc[1] += w0[1] * hi16(xv[0]); acc[2] += w0[2] * lo16(xv[1]); acc[3] += w0[3] * hi16(xv[1]);
                    acc[4] += w1[0] * lo16(xv[2]); acc[5] += w1[1] * hi16(xv[2]); acc[6] += w1[2] * lo16(xv[3]); acc[7] += w1[3] * hi16(xv[3]);
                }
                float ss = 0.f;
#pragma unroll
                for (int e = 0; e < 8; ++e) { acc[e] = siluf_(acc[e]); ss += acc[e] * acc[e]; }
                ss += __shfl_xor(ss, 1); ss += __shfl_xor(ss, 2); ss += __shfl_xor(ss, 4); ss += __shfl_xor(ss, 8);
                const float sc = part == 2 ? 1.f : rsqrtf(ss + 1e-6f) * (part == 0 ? 0.08838834764831845f : 1.f);
                u32x4 o = {pack2(acc[0] * sc, acc[1] * sc), pack2(acc[2] * sc, acc[3] * sc), pack2(acc[4] * sc, acc[5] * sc), pack2(acc[6] * sc, acc[7] * sc)};
                *(u32x4*)(dst + (seg * 8 + tt) * 136) = o;
            }
        } else if (tid >= 448) {
            const int t = tid - 448;
            const size_t ro = (size_t)(row0 + t) * N0;
            const float ba = bf2f(proj[ro + 3584 + h]), aa = bf2f(proj[ro + 3588 + h]);
            const float beta = sigmoidf_(ba);
            float g = -__expf(p.in[4][h]) * softplusf_(aa + p.in[5][h]);
#pragma unroll
            for (int o = 1; o < 64; o <<= 1) { const float tv = __shfl_up(g, o); if (lane >= o) g += tv; }
            gcs[t] = g; betas[t] = beta;
            const float glw = __builtin_bit_cast(float, __builtin_amdgcn_readlane(__builtin_bit_cast(int, g), 63)), eg = __expf(g);
            fac[t] = eg; fac[64 + t] = beta * eg; fac[128 + t] = __expf(glw - g);
        }
    }
    __syncthreads();
    const float gl = gcs[63];
    if (tid == 0) GT[item] = __expf(gl);
#pragma unroll
    for (int it = 0; it < 2; ++it) {
        const int idx = it * 512 + tid, t = idx >> 4, c8 = (idx & 15) * 8;
        const u32x4 q8 = *(const u32x4*)(qs + t * 136 + c8);
        const float eg = fac[t];
        u32x4 o2 = {pack2(lo16(q8[0]) * eg, hi16(q8[0]) * eg), pack2(lo16(q8[1]) * eg, hi16(q8[1]) * eg), pack2(lo16(q8[2]) * eg, hi16(q8[2]) * eg), pack2(lo16(q8[3]) * eg, hi16(q8[3]) * eg)};
        *(u32x4*)(QD + (size_t)(row0 + t) * 512 + h * 128 + c8) = o2;
    }
#pragma unroll
    for (int it = 0; it < 6; ++it) {
        const int u = it * 512 + tid, arr = u >> 10, rem = u & 1023, c = rem & 127, t8 = (rem >> 7) * 8;
        const bf16_t* src = (arr < 2 ? ks : vs) + c;
        bf16_t* dstT = (arr == 0 ? kbT : (arr == 1 ? kdTs : vbT)) + c * 72 + t8;
        float v[8];
#pragma unroll
        for (int j = 0; j < 8; ++j) {
            const float f = arr == 0 ? fac[64 + t8 + j] : (arr == 1 ? fac[128 + t8 + j] : betas[t8 + j]);
            v[j] = bf2f(src[(t8 + j) * 136]) * f;
        }
        u32x4 o = {pack2(v[0], v[1]), pack2(v[2], v[3]), pack2(v[4], v[5]), pack2(v[6], v[7])};
        *(u32x4*)dstT = o;
    }
    __syncthreads();
    {
        const int which = wv >> 2, mi = (wv >> 1) & 1, ni = wv & 1;
        const bf16_t* Ap = (which ? qs : ks) + (32 * mi + r) * 136 + 8 * hh;
        const bf16_t* Bp = ks + (32 * ni + r) * 136 + 8 * hh;
        f32x16 acc;
#pragma unroll
        for (int j = 0; j < 16; ++j) acc[j] = 0.f;
#pragma unroll
        for (int s = 0; s < 8; ++s) acc = MFMA32(*(const bf16x8*)(Ap + 16 * s), *(const bf16x8*)(Bp + 16 * s), acc);
        const int jt = 32 * ni + r; const float gj = gcs[jt];
#pragma unroll
        for (int j = 0; j < 16; ++j) {
            const int i = 32 * mi + crow(j, hh);
            const float dec = __expf(fminf(gcs[i] - gj, 0.f));
            if (which == 0) Mm[i * 64 + jt] = (jt < i) ? betas[i] * acc[j] * dec : 0.f;
            else GA[(size_t)item * 4096 + i * 64 + jt] = f2bf((jt <= i) ? acc[j] * dec : 0.f);
        }
    }
    __syncthreads();
#ifdef PROBE3
    { const unsigned long long tq = __builtin_amdgcn_s_memrealtime(); if (PROBE3 == 3) p3acc += tq - p3t; p3t = tq; }
#endif
    float* Tf = (float*)(lds + 116224);
    float* Xs = Tf + 4096;
    if (wv == 0) {
        const int d = lane >> 5, c = lane & 31;
        const float* Mb = Mm + (32 * d) * 64 + 32 * d;
        float x[32];
        f32x4 mc[8], mn[8];
#pragma unroll
        for (int q = 0; q < 8; ++q) { mc[q] = (f32x4){0.f, 0.f, 0.f, 0.f}; mn[q] = mc[q]; }
#pragma unroll
        for (int i = 0; i < 32; ++i) {
            if (i + 1 < 32) {
#pragma unroll
                for (int q = 0; q < (i + 4) / 4; ++q) mn[q] = *(const f32x4*)(Mb + (i + 1) * 64 + 4 * q);
            }
            __builtin_amdgcn_sched_barrier(0);
            float a0 = (i == c) ? 1.f : 0.f, a1 = 0.f;
#pragma unroll
            for (int l = 0; l < i; ++l) { if (l & 1) a1 -= mc[l >> 2][l & 3] * x[l]; else a0 -= mc[l >> 2][l & 3] * x[l]; }
            x[i] = a0 + a1;
            __builtin_amdgcn_sched_barrier(0);
#pragma unroll
            for (int q = 0; q < 8; ++q) mc[q] = mn[q];
        }
#pragma unroll
        for (int i = 0; i < 32; ++i) Tf[(32 * d + i) * 64 + 32 * d + c] = x[i];
        if (d == 0) {
#pragma unroll
            for (int i = 0; i < 32; ++i) Tf[i * 64 + 32 + c] = 0.f;
        }
    }
    __syncthreads();
#ifdef PROBE3
    { const unsigned long long tq = __builtin_amdgcn_s_memrealtime(); if (PROBE3 == 4) p3acc += tq - p3t; p3t = tq; }
#endif
    {
        const int i = tid >> 4, j0 = (tid & 15) * 2;
        float x0 = 0.f, x1 = 0.f;
#pragma unroll
        for (int q = 0; q < 8; ++q) {
            const f32x4 m = *(const f32x4*)(Mm + (32 + i) * 64 + 4 * q);
#pragma unroll
            for (int e = 0; e < 4; ++e) { const f32x2v t = *(const f32x2v*)(Tf + (4 * q + e) * 64 + j0); x0 += m[e] * t[0]; x1 += m[e] * t[1]; }
        }
        Xs[i * 33 + j0] = x0; Xs[i * 33 + j0 + 1] = x1;
    }
    __syncthreads();
#ifdef PROBE3
    { const unsigned long long tq = __builtin_amdgcn_s_memrealtime(); if (PROBE3 == 5) p3acc += tq - p3t; p3t = tq; }
#endif
    {
        const int i = tid >> 4, j0 = (tid & 15) * 2;
        float x0 = 0.f, x1 = 0.f;
#pragma unroll
        for (int q = 0; q < 8; ++q) {
            const f32x4 m = *(const f32x4*)(Tf + (32 + i) * 64 + 32 + 4 * q);
#pragma unroll
            for (int e = 0; e < 4; ++e) { x0 += m[e] * Xs[(4 * q + e) * 33 + j0]; x1 += m[e] * Xs[(4 * q + e) * 33 + j0 + 1]; }
        }
        Tf[(32 + i) * 64 + j0] = -x0; Tf[(32 + i) * 64 + j0 + 1] = -x1;
    }
    __syncthreads();
#ifdef PROBE3
    { const unsigned long long tq = __builtin_amdgcn_s_memrealtime(); if (PROBE3 == 6) p3acc += tq - p3t; p3t = tq; }
#endif
    {
        const int row = tid >> 3, c0 = (tid & 7) * 8;
        const f32x4 t0 = *(const f32x4*)(Tf + row * 64 + c0), t1 = *(const f32x4*)(Tf + row * 64 + c0 + 4);
        u32x4 o = {pack2(t0[0], t0[1]), pack2(t0[2], t0[3]), pack2(t1[0], t1[1]), pack2(t1[2], t1[3])};
        *(u32x4*)(Tm + row * 72 + c0) = o;
    }
    __syncthreads();
#ifdef PROBE3
    { const unsigned long long tq = __builtin_amdgcn_s_memrealtime(); if (PROBE3 == 7) p3acc += tq - p3t; p3t = tq; }
#endif
    {
        const int dt = wv >> 1, it = wv & 1;
        f32x16 au, aw;
#pragma unroll
        for (int j = 0; j < 16; ++j) { au[j] = 0.f; aw[j] = 0.f; }
#pragma unroll
        for (int s = 0; s < 4; ++s) {
            const bf16x8 bT = *(const bf16x8*)(Tm + (32 * it + r) * 72 + 16 * s + 8 * hh);
            au = MFMA32(*(const bf16x8*)(vbT + (32 * dt + r) * 72 + 16 * s + 8 * hh), bT, au);
            aw = MFMA32(*(const bf16x8*)(kbT + (32 * dt + r) * 72 + 16 * s + 8 * hh), bT, aw);
        }
#pragma unroll
        for (int j = 0; j < 16; ++j) UT[(size_t)item * 8192 + (32 * dt + crow(j, hh)) * 64 + 32 * it + r] = f2bf(au[j]);
#pragma unroll
        for (int g = 0; g < 4; ++g) {
            u32x2 o = {pack2(-aw[4 * g], -aw[4 * g + 1]), pack2(-aw[4 * g + 2], -aw[4 * g + 3])};
            *(u32x2*)(Wg + (size_t)(row0 + 32 * it + r) * 512 + h * 128 + 32 * dt + 8 * g + 4 * hh) = o;
        }
    }
#pragma unroll
    for (int it = 0; it < 2; ++it) {
        const int c = it * 512 + tid, dk = c >> 3, t8 = (c & 7) * 8;
        *(u32x4*)(KDT + (size_t)item * 8192 + dk * 64 + t8) = *(const u32x4*)(kdTs + dk * 72 + t8);
    }
    __syncthreads();
#ifdef PROBE3
    { const unsigned long long tq = __builtin_amdgcn_s_memrealtime(); if (PROBE3 == 8) p3acc += tq - p3t; p3t = tq; }
#endif
#ifdef PROBE3
    if (threadIdx.x == 0 && blockIdx.x == 0) ((unsigned*)(p.ws + WS_CTL))[96] += (unsigned)p3acc;
#endif
}

struct HgIn { u32x4 i8a, i8b, q8a, q8b, f8a, f8b; };
DI void hg_prep_load(const P& p, int item, int tid, HgIn& in) {
    const int lane = tid & 63, wv = tid >> 6;
    const int n = item % NCH, hb = item / NCH, h = hb & 7, b = hb >> 3;
    const bf16_t* rp = (const bf16_t*)(p.ws + WS_R1) + (size_t)(b * TT + n * 64 + lane) * LD1 + h * 128 + 16 * wv;
    in.i8a = *(const u32x4*)(rp + 2048); in.i8b = *(const u32x4*)(rp + 2056);
    in.q8a = *(const u32x4*)rp; in.q8b = *(const u32x4*)(rp + 8);
    in.f8a = *(const u32x4*)(rp + 1024); in.f8b = *(const u32x4*)(rp + 1032);
}
DI void hg_prep_item(const P& p, int item, int next_item, unsigned char* lds, int tid, HgIn& in) {
    const int lane = tid & 63, wv = tid >> 6, r = lane & 31, hh = lane >> 5;
    const int n = item % NCH, hb = item / NCH, h = hb & 7, b = hb >> 3;
    const int row0 = b * TT + n * 64;
    bf16_t* proj = (bf16_t*)(p.ws + WS_R1);
    bf16_t* qs = (bf16_t*)lds;
    bf16_t* ks = qs + 64 * 136;
    bf16_t* HA = (bf16_t*)((unsigned char*)p.out + DO_HA); float* DVEC = (float*)((unsigned char*)p.out + DO_DVEC);
    const float* lbr = p.in[9];
    const int c0 = 16 * wv;
    bf16_t* rp = proj + (size_t)(row0 + lane) * LD1 + h * 128 + c0;
    const u32x4 i8a = in.i8a, i8b = in.i8b, q8a = in.q8a, q8b = in.q8b, f8a = in.f8a, f8b = in.f8b;
    float lf[16], kk[16], qq[16];
#pragma unroll
    for (int e = 0; e < 16; ++e) {
        const unsigned fw = (e < 8) ? f8a[(e & 7) >> 1] : f8b[(e & 7) >> 1], qw = (e < 8) ? q8a[(e & 7) >> 1] : q8b[(e & 7) >> 1];
        const float fv = (e & 1) ? hi16(fw) : lo16(fw), qv = (e & 1) ? hi16(qw) : lo16(qw);
        const float lb = ((const float*)(lds + 36864))[h * 128 + c0 + e];
        const float sg = sigmoidf_(fv);
        kk[e] = (1.f - lb) * (1.f - sg);
        lf[e] = 1.f - kk[e];
        qq[e] = siluf_(qv);
    }
    asm volatile("" :: "v"(i8a[3]), "v"(i8b[3]), "v"(q8b[3]), "v"(f8b[3]));
    if (next_item >= 0) hg_prep_load(p, next_item, tid, in);
    asm volatile("s_waitcnt lgkmcnt(0)\n\ts_barrier" ::: "memory");
#pragma unroll
    for (int e = 0; e < 16; ++e) {
        float x = lf[e];
        const int one = __builtin_bit_cast(int, 1.0f);
        x *= __builtin_bit_cast(float, __builtin_amdgcn_update_dpp(one, __builtin_bit_cast(int, x), 0x111, 0xf, 0xf, false));
        x *= __builtin_bit_cast(float, __builtin_amdgcn_update_dpp(one, __builtin_bit_cast(int, x), 0x112, 0xf, 0xf, false));
        x *= __builtin_bit_cast(float, __builtin_amdgcn_update_dpp(one, __builtin_bit_cast(int, x), 0x114, 0xf, 0xf, false));
        x *= __builtin_bit_cast(float, __builtin_amdgcn_update_dpp(one, __builtin_bit_cast(int, x), 0x118, 0xf, 0xf, false));
        const float r0 = __builtin_bit_cast(float, __builtin_amdgcn_readlane(__builtin_bit_cast(int, x), 15));
        const float r1 = __builtin_bit_cast(float, __builtin_amdgcn_readlane(__builtin_bit_cast(int, x), 31));
        const float r2 = __builtin_bit_cast(float, __builtin_amdgcn_readlane(__builtin_bit_cast(int, x), 47));
        x *= (lane >= 48) ? (r0 * r1 * r2) : (lane >= 32) ? (r0 * r1) : (lane >= 16) ? r0 : 1.f;
        lf[e] = x;
    }
    float qv[16], kh[16];
#pragma unroll
    for (int e = 0; e < 16; ++e) {
        const float ef = lf[e];
        const float ebl = __builtin_bit_cast(float, __builtin_amdgcn_readlane(__builtin_bit_cast(int, ef), 63));
        qv[e] = qq[e] * ef; kh[e] = kk[e] * __builtin_amdgcn_rcpf(ef);
        const int dk = c0 + e;
        bf16_t* dp = proj + (size_t)(row0 + (dk >> 1)) * LD1 + h * 128 + (dk & 1) * 64 + lane;
        dp[1024] = f2bf(kh[e] * ebl);
        const unsigned iw = (e < 8) ? i8a[(e & 7) >> 1] : i8b[(e & 7) >> 1];
        dp[2048] = (unsigned short)((e & 1) ? (iw >> 16) : (iw & 0xffffu));
        if (lane == 63) DVEC[(size_t)item * 128 + dk] = ebl;
    }
    {
        u32x4 qa = {pack2(qv[0], qv[1]), pack2(qv[2], qv[3]), pack2(qv[4], qv[5]), pack2(qv[6], qv[7])};
        u32x4 qb = {pack2(qv[8], qv[9]), pack2(qv[10], qv[11]), pack2(qv[12], qv[13]), pack2(qv[14], qv[15])};
        u32x4 ka = {pack2(kh[0], kh[1]), pack2(kh[2], kh[3]), pack2(kh[4], kh[5]), pack2(kh[6], kh[7])};
        u32x4 kb = {pack2(kh[8], kh[9]), pack2(kh[10], kh[11]), pack2(kh[12], kh[13]), pack2(kh[14], kh[15])};
        *(u32x4*)(qs + lane * 136 + c0) = qa; *(u32x4*)(qs + lane * 136 + c0 + 8) = qb;
        *(u32x4*)(ks + lane * 136 + c0) = ka; *(u32x4*)(ks + lane * 136 + c0 + 8) = kb;
        *(u32x4*)rp = qa; *(u32x4*)(rp + 8) = qb;
    }
    asm volatile("s_waitcnt lgkmcnt(0)\n\ts_barrier" ::: "memory");
    if (wv < 4) {
        const int mi = wv >> 1, ni = wv & 1;
        const bf16_t* Ap = qs + (32 * mi + r) * 136 + 8 * hh;
        const bf16_t* Bp = ks + (32 * ni + r) * 136 + 8 * hh;
        f32x16 acc;
#pragma unroll
        for (int j = 0; j < 16; ++j) acc[j] = 0.f;
#pragma unroll
        for (int s = 0; s < 8; ++s) acc = MFMA32(*(const bf16x8*)(Ap + 16 * s), *(const bf16x8*)(Bp + 16 * s), acc);
        const int jt = 32 * ni + r;
#pragma unroll
        for (int j = 0; j < 16; ++j) { const int i = 32 * mi + crow(j, hh); HA[(size_t)item * 4096 + i * 64 + jt] = f2bf((jt <= i) ? acc[j] : 0.f); }
    }
}

struct ScanPtrs { const bf16_t *qd, *wq, *Am, *kdT, *uT, *zg; const float *dvec, *gn; bf16_t* outp; int qld, zld; size_t cs; int s2; };
constexpr int SC_W = 0, SC_Q = 16896, SC_A = 33792, SC_K = 42496, SC_U = 59904, SC_O = 77312, SC_D = 144896, SC_G = 145408;
template <int KIND>
DI void scan_issue(const ScanPtrs& sp, int n, int lt, u32x4 (&rw)[4], u32x4 (&rq)[4], u32x4 (&ra)[2], u32x4 (&rk)[4], u32x4 (&ru)[4], f32x4& rd) {
    const int t0 = n * 64;
#pragma unroll
    for (int i = 0; i < 4; ++i) {
        const int c = i * 256 + lt, row = c >> 4, col = (c & 15) * 8;
        if (KIND == 0) rw[i] = *(const u32x4*)(sp.wq + (size_t)(t0 + row) * sp.qld + col);
        rq[i] = *(const u32x4*)(sp.qd + (size_t)(t0 + row) * sp.qld + col);
    }
#pragma unroll
    for (int i = 0; i < 2; ++i) { const int c = i * 256 + lt, row = c >> 3, col = (c & 7) * 8; ra[i] = *(const u32x4*)(sp.Am + (size_t)n * 4096 + row * 64 + col); }
#pragma unroll
    for (int i = 0; i < 4; ++i) {
        const int c = i * 256 + lt, dk = c >> 3, t8 = (c & 7) * 8;
        const size_t off = (size_t)n * sp.cs + (size_t)(dk >> 1) * sp.s2 + (dk & 1) * 64 + t8;
        rk[i] = *(const u32x4*)(sp.kdT + off); ru[i] = *(const u32x4*)(sp.uT + off);
    }
    if (lt < 32) { if (KIND == 0) { const float d = sp.dvec[n]; rd = (f32x4){d, d, d, d}; } else rd = *(const f32x4*)(sp.dvec + (size_t)n * 128 + lt * 4); }
}
DI void st16(bf16_t* p, const u32x4& v) { *(u32x2*)p = (u32x2){v[0], v[1]}; *(u32x2*)(p + 4) = (u32x2){v[2], v[3]}; }
template <int KIND>
DI void scan_fill(unsigned char* lds, int lt, const u32x4 (&rw)[4], const u32x4 (&rq)[4], const u32x4 (&ra)[2], const u32x4 (&rk)[4], const u32x4 (&ru)[4], const f32x4& rd) {
#pragma unroll
    for (int i = 0; i < 4; ++i) {
        const int c = i * 256 + lt, row = c >> 4, col = (c & 15) * 8;
        if (KIND == 0) st16((bf16_t*)(lds + SC_W) + row * 132 + col, rw[i]);
        st16((bf16_t*)(lds + SC_Q) + row * 132 + col, rq[i]);
    }
#pragma unroll
    for (int i = 0; i < 2; ++i) { const int c = i * 256 + lt, row = c >> 3, col = (c & 7) * 8; st16((bf16_t*)(lds + SC_A) + row * 68 + col, ra[i]); }
#pragma unroll
    for (int i = 0; i < 4; ++i) {
        const int c = i * 256 + lt, dk = c >> 3, t8 = (c & 7) * 8;
        st16((bf16_t*)(lds + SC_K) + dk * 68 + t8, rk[i]); st16((bf16_t*)(lds + SC_U) + dk * 68 + t8, ru[i]);
    }
    if (lt < 32) *(f32x4*)((float*)(lds + SC_D) + lt * 4) = rd;
}
DI void scan_zload(const ScanPtrs& sp, int m, int lt, u32x4 (&zr)[4]) {
    const int row = lt >> 2, c0 = (lt & 3) * 32;
    const bf16_t* zp = sp.zg + (size_t)(m * 64 + row) * sp.zld + c0;
#pragma unroll
    for (int i = 0; i < 4; ++i) zr[i] = *(const u32x4*)(zp + 8 * i);
}
DI void scan_epilogue(const ScanPtrs& sp, unsigned char* lds, int m, int lt, const u32x4 (&zr)[4]) {
    const int row = lt >> 2, c0 = (lt & 3) * 32;
    const float* ob = (const float*)(lds + SC_O) + (m & 1) * 64 * 132 + row * 132 + c0;
    const float* gl = (const float*)(lds + SC_G) + c0;
    float ss = 0.f;
#pragma unroll
    for (int i = 0; i < 8; ++i) { const f32x4 v = *(const f32x4*)(ob + 4 * i); ss += v[0] * v[0] + v[1] * v[1] + v[2] * v[2] + v[3] * v[3]; }
    ss += __shfl_xor(ss, 1); ss += __shfl_xor(ss, 2);
    const float inv = rsqrtf(ss * (1.f / 128.f) + 1e-6f);
    bf16_t* op = sp.outp + (size_t)(m * 64 + row) * DM + c0;
#pragma unroll
    for (int i = 0; i < 8; ++i) {
        const f32x4 g0 = *(const f32x4*)(gl + 4 * i);
        const f32x4 a = *(const f32x4*)(ob + 4 * i);
        const unsigned z0 = zr[i >> 1][(i & 1) * 2], z1 = zr[i >> 1][(i & 1) * 2 + 1];
        u32x2 o;
        o[0] = pack2(a[0] * inv * g0[0] * lo16(z0), a[1] * inv * g0[1] * hi16(z0));
        o[1] = pack2(a[2] * inv * g0[2] * lo16(z1), a[3] * inv * g0[3] * hi16(z1));
        *(u32x2*)(op + 4 * i) = o;
    }
}
template <int KIND>
DI void scan_chain(const P& p, int chain, unsigned char* lds) {
#if defined(PROBE2) && PROBE2 == 4
    const unsigned long long e0 = __builtin_amdgcn_s_memrealtime();
#endif
    const int tid = my_tid(), lane = tid & 63, wv = __builtin_amdgcn_readfirstlane(tid >> 6), r = lane & 31, hh = lane >> 5, lt = tid - 256;
    const int h = KIND == 0 ? (chain & 3) : (chain & 7), b = KIND == 0 ? (chain >> 2) : (chain >> 3);
    const size_t rb = (size_t)b * TT;
    const bf16_t* r1 = (const bf16_t*)(p.ws + WS_R1);
    ScanPtrs sp;
    if (KIND == 0) {
        sp.qd = (const bf16_t*)((unsigned char*)p.out + DO_QD) + rb * 512 + h * 128; sp.wq = (const bf16_t*)((unsigned char*)p.out + DO_W) + rb * 512 + h * 128; sp.qld = 512;
        sp.Am = (const bf16_t*)(p.ws + WS_GA) + (size_t)chain * NCH * 4096;
        sp.kdT = (const bf16_t*)(p.ws + WS_KDT) + (size_t)chain * NCH * 8192; sp.uT = (const bf16_t*)((unsigned char*)p.out + DO_UT) + (size_t)chain * NCH * 8192; sp.cs = 8192; sp.s2 = 128;
        sp.dvec = (const float*)(p.ws + WS_GT) + (size_t)chain * NCH; sp.zg = r1 + rb * N0 + 1536 + h * 128; sp.zld = N0; sp.gn = p.in[6];
    } else {
        sp.qd = r1 + rb * LD1 + h * 128; sp.wq = sp.qd; sp.qld = LD1;
        sp.Am = (const bf16_t*)((unsigned char*)p.out + DO_HA) + (size_t)chain * NCH * 4096;
        sp.kdT = r1 + rb * LD1 + 1024 + h * 128; sp.uT = r1 + rb * LD1 + 2048 + h * 128; sp.cs = (size_t)64 * LD1; sp.s2 = LD1;
        sp.dvec = (const float*)((unsigned char*)p.out + DO_DVEC) + (size_t)chain * NCH * 128; sp.zg = r1 + rb * LD1 + 3072 + h * 128; sp.zld = LD1; sp.gn = p.in[10];
    }
    sp.outp = (bf16_t*)(p.ws + WS_MIX) + rb * DM + h * 128;
    const bf16_t* Wl = (const bf16_t*)(lds + SC_W); const bf16_t* Ql = (const bf16_t*)(lds + SC_Q); const bf16_t* Al = (const bf16_t*)(lds + SC_A);
    const bf16_t* Kl = (const bf16_t*)(lds + SC_K); const bf16_t* Ul = (const bf16_t*)(lds + SC_U); const float* Dl = (const float*)(lds + SC_D);
    float* obuf = (float*)(lds + SC_O);
    u32x4 rwA[4], rqA[4], raA[2], rkA[4], ruA[4]; f32x4 rdA = {0.f, 0.f, 0.f, 0.f};
    u32x4 rwB[4], rqB[4], raB[2], rkB[4], ruB[4]; f32x4 rdB = {0.f, 0.f, 0.f, 0.f};
    if (wv >= 4) {
        if (lt < 32) *(f32x4*)((float*)(lds + SC_G) + lt * 4) = *(const f32x4*)(sp.gn + lt * 4);
        scan_issue<KIND>(sp, 1, lt, rwB, rqB, raB, rkB, ruB, rdB);
        scan_issue<KIND>(sp, 2, lt, rwA, rqA, raA, rkA, ruA, rdA);
        scan_fill<KIND>(lds, lt, rwB, rqB, raB, rkB, ruB, rdB);
    }
    __syncthreads();
    const int dv0 = 32 * wv;
#define SCHED __builtin_amdgcn_sched_barrier(0)
#define LBAR() asm volatile("s_waitcnt lgkmcnt(0)\n\ts_barrier" ::: "memory")
#define LW(f, base, half) do { _Pragma("unroll") for (int _i = 0; _i < 4; ++_i) f[_i] = loadA((base) + 32 * (((half) * 4 + _i) >> 1) + 16 * (_i & 1)); } while (0)
#define MS(acc, f, half) do { _Pragma("unroll") for (int _i = 0; _i < 4; ++_i) acc = MFMA32(f[_i], Sb[((half) * 4 + _i) >> 1][_i & 1], acc); } while (0)
#define LK(f, kt) do { _Pragma("unroll") for (int _i = 0; _i < 4; ++_i) f[_i] = loadA(Kl + (32 * (kt) + r) * 68 + 32 * (_i >> 1) + 16 * (_i & 1) + 4 * hh); \
                       _Pragma("unroll") for (int _g = 0; _g < 4; ++_g) dcy[_g] = *(const f32x4*)(Dl + 32 * (kt) + 8 * _g + 4 * hh); } while (0)
#define SU(kt, f) do { _Pragma("unroll") for (int _g = 0; _g < 4; ++_g) _Pragma("unroll") for (int _e = 0; _e < 4; ++_e) S[kt][4 * _g + _e] *= dcy[_g][_e]; \
                       _Pragma("unroll") for (int _i = 0; _i < 4; ++_i) S[kt] = MFMA32(f[_i], vb[_i >> 1][_i & 1], S[kt]); } while (0)
#if defined(PROBE2) && PROBE2 == 4
    if (KIND == 0 && threadIdx.x == 0 && blockIdx.x == 0) ((unsigned*)(p.ws + WS_CTL))[96] = (unsigned)(__builtin_amdgcn_s_memrealtime() - e0);
#endif
    if (wv < 4) {
        f32x16 S[4];
#pragma unroll
        for (int kt = 0; kt < 4; ++kt)
#pragma unroll
            for (int j = 0; j < 16; ++j) S[kt][j] = 0.f;
#ifdef PROBE_SEL
        unsigned long long tacc = 0ull;
#endif
#pragma unroll 1
        for (int n = 1; n < NCH; ++n) {
#ifdef PROBE_SEL
            const unsigned long long pt0 = __builtin_amdgcn_s_memrealtime();
#endif
            u32x4 zr[4];
            scan_zload(sp, n, tid, zr);
            bf16x8 f0[4], f1[4];
            f32x16 vn[2], o[2];
            f32x4 dcy[4];
            const bf16_t* w0 = Wl + r * 132 + 4 * hh; const bf16_t* w1 = Wl + (32 + r) * 132 + 4 * hh;
            const bf16_t* q0 = Ql + r * 132 + 4 * hh; const bf16_t* q1 = Ql + (32 + r) * 132 + 4 * hh;
            if (KIND == 0) { LW(f0, w0, 0); LW(f1, w0, 1); } else { LW(f0, q0, 0); LW(f1, q0, 1); }
            const bf16_t* up = Ul + (dv0 + r) * 68 + 4 * hh;
            if (KIND == 0) {
#pragma unroll
                for (int mt = 0; mt < 2; ++mt)
#pragma unroll
                    for (int g = 0; g < 4; ++g) {
                        const u32x2 raw = *(const u32x2*)(up + 32 * mt + 8 * g);
                        vn[mt][4 * g] = lo16(raw[0]); vn[mt][4 * g + 1] = hi16(raw[0]); vn[mt][4 * g + 2] = lo16(raw[1]); vn[mt][4 * g + 3] = hi16(raw[1]);
                    }
            }
            bf16x8 Sb[4][2];
#pragma unroll
            for (int kt = 0; kt < 4; ++kt) { Sb[kt][0] = pack8(S[kt], 0); Sb[kt][1] = pack8(S[kt], 1); }
            SCHED;
            if (KIND == 0) {
                MS(vn[0], f0, 0); SCHED; LW(f0, w1, 0); SCHED; MS(vn[0], f1, 1);
                SCHED; LW(f1, w1, 1); SCHED;
                MS(vn[1], f0, 0); SCHED; LW(f0, q0, 0); SCHED; MS(vn[1], f1, 1);
                SCHED; LW(f1, q0, 1); SCHED;
            }
#pragma unroll
            for (int j = 0; j < 16; ++j) { o[0][j] = 0.f; o[1][j] = 0.f; }
            MS(o[0], f0, 0); SCHED; LW(f0, q1, 0); SCHED; MS(o[0], f1, 1); SCHED; LW(f1, q1, 1); SCHED;
            MS(o[1], f0, 0); SCHED;
            f0[0] = loadA(Al + r * 68 + 4 * hh); f0[1] = loadA(Al + r * 68 + 16 + 4 * hh); f0[2] = loadA(Al + (32 + r) * 68 + 4 * hh);
            SCHED; MS(o[1], f1, 1);
            bf16x8 vb[2][2];
            if (KIND == 0) {
#pragma unroll
                for (int mt = 0; mt < 2; ++mt) { vb[mt][0] = pack8(vn[mt], 0); vb[mt][1] = pack8(vn[mt], 1); }
            } else {
#pragma unroll
                for (int mt = 0; mt < 2; ++mt) { vb[mt][0] = loadA(up + 32 * mt); vb[mt][1] = loadA(up + 32 * mt + 16); }
            }
            SCHED;
            f1[0] = loadA(Al + (32 + r) * 68 + 16 + 4 * hh); f1[1] = loadA(Al + (32 + r) * 68 + 32 + 4 * hh); f1[2] = loadA(Al + (32 + r) * 68 + 48 + 4 * hh);
            SCHED;
            o[0] = MFMA32(f0[0], vb[0][0], o[0]); o[1] = MFMA32(f0[2], vb[0][0], o[1]); o[0] = MFMA32(f0[1], vb[0][1], o[0]);
            SCHED; LK(f0, 0); SCHED;
            o[1] = MFMA32(f1[0], vb[0][1], o[1]); o[1] = MFMA32(f1[1], vb[1][0], o[1]); o[1] = MFMA32(f1[2], vb[1][1], o[1]);
            SCHED;
            SU(0, f0); SCHED; LK(f1, 1); SCHED; SU(1, f1); SCHED; LK(f0, 2); SCHED; SU(2, f0); SCHED; LK(f1, 3); SCHED; SU(3, f1);
            float* ob = obuf + (n & 1) * 64 * 132 + dv0 + r;
#pragma unroll
            for (int mt = 0; mt < 2; ++mt)
#pragma unroll
                for (int j = 0; j < 16; ++j) ob[(32 * mt + crow(j, hh)) * 132] = o[mt][j];
#ifdef PROBE_SEL
            asm volatile("s_waitcnt lgkmcnt(0)" ::: "memory");
            const unsigned long long pt1 = __builtin_amdgcn_s_memrealtime();
            LBAR();
            const unsigned long long pt2 = __builtin_amdgcn_s_memrealtime();
            scan_epilogue(sp, lds, n, tid, zr);
            LBAR();
            const unsigned long long pt3 = __builtin_amdgcn_s_memrealtime();
            tacc += (PROBE_SEL == 1) ? (pt1 - pt0) : (PROBE_SEL == 2) ? (pt2 - pt1) : (pt3 - pt2);
#else
            LBAR();
            scan_epilogue(sp, lds, n, tid, zr);
            LBAR();
#endif
        }
#ifdef PROBE_SEL
        if (KIND == PROBE_KIND && blockIdx.x == 0 && wv == 0) {
            const unsigned long long ps = __builtin_amdgcn_s_memrealtime();
            while (__builtin_amdgcn_s_memrealtime() - ps < tacc * PROBE_MUL) __builtin_amdgcn_s_sleep(8);
        }
#endif
    } else {
#define LBODY(n_, XW, XQ, XA, XK, XU, XD, YW, YQ, YA, YK, YU, YD, ZC, ZN) do { \
            if ((n_) + 2 < NCH) scan_issue<KIND>(sp, (n_) + 2, lt, YW, YQ, YA, YK, YU, YD); \
            LBAR(); \
            if ((n_) + 1 < NCH) scan_fill<KIND>(lds, lt, XW, XQ, XA, XK, XU, XD); \
            LBAR(); } while (0)
#pragma unroll 1
        for (int n = 1; n < NCH; n += 2) {
            LBODY(n, rwA, rqA, raA, rkA, ruA, rdA, rwB, rqB, raB, rkB, ruB, rdB, zrB, zrA);
            if (n + 1 < NCH) LBODY(n + 1, rwB, rqB, raB, rkB, ruB, rdB, rwA, rqA, raA, rkA, ruA, rdA, zrA, zrB);
        }
#undef LBODY
    }
#undef SCHED
#undef LBAR
#undef LW
#undef MS
#undef LK
#undef SU
    __syncthreads();
}

DI void sb_item(const P& p, int item, bf16_t* vT  , int lane) {
    const int r = lane & 31, hh = lane >> 5;
    const int qt = 131 - (item >> 6), bh = item & 63, b = bh >> 3, h = bh & 7;
    const bf16_t* base = (const bf16_t*)(p.ws + WS_R1) + (size_t)b * TT * N0;
    const int q0 = 32 * qt, qpos = q0 + r;
    bf16x8 qf[4];
#pragma unroll
    for (int s = 0; s < 4; ++s) qf[s] = *(const bf16x8*)(base + (size_t)(q0 + r) * N0 + 2048 + h * 64 + 16 * s + 8 * hh);
    f32x16 o[2];
#pragma unroll
    for (int j = 0; j < 16; ++j) { o[0][j] = 0.f; o[1][j] = 0.f; }
    float R = 0.f;
#pragma unroll 1
    for (int kt = qt; kt >= 3; --kt) {
        const int k0 = 32 * kt;
        f32x16 z;
#pragma unroll
        for (int j = 0; j < 16; ++j) z[j] = 0.f;
#pragma unroll
        for (int s = 0; s < 4; ++s) z = MFMA32(*(const bf16x8*)(base + (size_t)(k0 + r) * N0 + 2560 + h * 64 + 16 * s + 8 * hh), qf[s], z);
#pragma unroll
        for (int i = 0; i < 4; ++i) {
            const int c = i * 64 + lane, key = c >> 3, d0 = (c & 7) * 8;
            const u32x4 v8 = *(const u32x4*)(base + (size_t)(k0 + key) * N0 + 3072 + h * 64 + d0);
#pragma unroll
            for (int e = 0; e < 8; ++e) vT[(d0 + e) * 36 + key] = (unsigned short)((e & 1) ? (v8[e >> 1] >> 16) : (v8[e >> 1] & 0xffffu));
        }
        float l[16], ls[16], suf[16]; bool al[16];
#pragma unroll
        for (int j = 0; j < 16; ++j) {
            const int key = k0 + crow(j, hh);
            const float zz = z[j] * 0.125f;
            al[j] = (key < qpos) && (key >= PADF);
            const float sp = softplusf_(zz);
            l[j] = al[j] ? -sp : 0.f; ls[j] = zz - sp;
        }
        float G[4], Pg[4], offs[4];
#pragma unroll
        for (int g = 0; g < 4; ++g) {
            suf[4 * g + 3] = 0.f; suf[4 * g + 2] = l[4 * g + 3]; suf[4 * g + 1] = suf[4 * g + 2] + l[4 * g + 2]; suf[4 * g] = suf[4 * g + 1] + l[4 * g + 1];
            G[g] = suf[4 * g] + l[4 * g];
            Pg[g] = __shfl_xor(G[g], 32);
        }
        float tail = 0.f;
#pragma unroll
        for (int g = 3; g >= 0; --g) { offs[g] = tail + (hh == 0 ? Pg[g] : 0.f); tail += G[g] + Pg[g]; }
        f32x16 pw;
#pragma unroll
        for (int j = 0; j < 16; ++j) pw[j] = al[j] ? __expf(ls[j] + R + offs[j >> 2] + suf[j]) : 0.f;
        R += tail;
        const bf16x8 pb0 = pack8(pw, 0), pb1 = pack8(pw, 1);
#pragma unroll
        for (int mt = 0; mt < 2; ++mt) {
            o[mt] = MFMA32(loadA(vT + (32 * mt + r) * 36 + 4 * hh), pb0, o[mt]);
            o[mt] = MFMA32(loadA(vT + (32 * mt + r) * 36 + 16 + 4 * hh), pb1, o[mt]);
        }
        if (__ballot(R > -105.f) == 0ull) break;
    }
    bf16_t* op = (bf16_t*)(p.ws + WS_MIX) + ((size_t)b * TT + q0 + r) * DM + 512 + h * 64 + 4 * hh;
#pragma unroll
    for (int mt = 0; mt < 2; ++mt)
#pragma unroll
        for (int g = 0; g < 4; ++g) {
            u32x2 w = {pack2(o[mt][4 * g], o[mt][4 * g + 1]), pack2(o[mt][4 * g + 2], o[mt][4 * g + 3])};
            *(u32x2*)(op + 32 * mt + 8 * g) = w;
        }
}

#define XB_TMO      128
#define XB_XCNT(j)  (256  + 64 * (j))
#define XB_XSUB(j)  (1280 + 64 * (j))
#define XB_XGEN(j)  (2304 + 64 * (j))
#define XB_TOP      3328
#define XB_TOPGEN   3392
#define XCD_BAR_WORDS 3456
#define XB_SPIN_CAP (1u << 18)
#define LAS __attribute__((address_space(3)))

__device__ __forceinline__ unsigned xb_ld(unsigned* p)              { return __hip_atomic_load(p, __ATOMIC_RELAXED, __HIP_MEMORY_SCOPE_AGENT); }
__device__ __forceinline__ unsigned xb_add(unsigned* p, unsigned v) { return __hip_atomic_fetch_add(p, v, __ATOMIC_RELAXED, __HIP_MEMORY_SCOPE_AGENT); }
__device__ __forceinline__ unsigned xb_xcc_id() { return (unsigned)__builtin_amdgcn_s_getreg((3 << 11) | 20) & 0xFu; }
#define XB_SPIN(cond, bar) do { unsigned _sp = 0; while (cond) { __builtin_amdgcn_s_sleep(1); \
    if ((++_sp & 255u) == 0u) { if (xb_ld(&(bar)[XB_TMO])) break; if (_sp > XB_SPIN_CAP) { atomicAdd(&(bar)[XB_TMO], 1u); break; } } } } while (0)

struct XcdBarrier {
    unsigned* bar; unsigned x;
    volatile LAS unsigned* st;
};

__device__ __forceinline__ XcdBarrier xcd_barrier_post(unsigned* bar, volatile LAS unsigned* st) {
    XcdBarrier b; b.bar = bar; b.x = xb_xcc_id(); b.st = st;
    if (threadIdx.x == 0) (void)xb_add(&bar[XB_XCNT(b.x)], 1u);
    return b;
}
__device__ __forceinline__ void xcd_barrier_complete(unsigned* bar, unsigned x, unsigned& nloc, unsigned& nx) {
    const unsigned G = gridDim.x * gridDim.y * gridDim.z;
    unsigned sum, cnt, mine, sp = 0u;
    for (;;) {
        sum = 0u; cnt = 0u; mine = 0u;
#pragma unroll
        for (unsigned j = 0; j < 16; ++j) { const unsigned c = xb_ld(&bar[XB_XCNT(j)]); sum += c; cnt += (c > 0u) ? 1u : 0u; mine = (j == x) ? c : mine; }
        if (sum == G) break;
        __builtin_amdgcn_s_sleep(1);
        if ((++sp & 255u) == 0u) { if (xb_ld(&bar[XB_TMO])) break; if (sp > XB_SPIN_CAP) { atomicAdd(&bar[XB_TMO], 1u); break; } }
    }
    nloc = mine > 0u ? mine : 1u; nx = cnt > 0u ? cnt : 1u;
}

__device__ __forceinline__ void xcd_barrier(const XcdBarrier& b) {
    asm volatile("s_waitcnt vmcnt(0)" ::: "memory");
    __syncthreads();
    if (threadIdx.x == 0) {
        unsigned* bar = b.bar;
        __builtin_amdgcn_s_waitcnt(0);
        unsigned nloc = b.st[0], nx = b.st[1];
        if (nloc == 0u) { xcd_barrier_complete(bar, b.x, nloc, nx); b.st[0] = nloc; b.st[1] = nx; }
        const unsigned old = xb_add(&bar[XB_XSUB(b.x)], 1u);
        const unsigned gen = old / nloc;
        if (old + 1u == (gen + 1u) * nloc) {
            __builtin_amdgcn_fence(__ATOMIC_RELEASE, "agent");
            asm volatile("s_waitcnt vmcnt(0)" ::: "memory");
            const unsigned og = xb_add(&bar[XB_TOP], 1u);
            const unsigned tg = og / nx;
            if (og + 1u == (tg + 1u) * nx) xb_add(&bar[XB_TOPGEN], 1u);
            else XB_SPIN(xb_ld(&bar[XB_TOPGEN]) == tg, bar);
            __builtin_amdgcn_fence(__ATOMIC_ACQUIRE, "agent");
            xb_add(&bar[XB_XGEN(b.x)], 1u);
            asm volatile("s_waitcnt vmcnt(0)" ::: "memory");
        } else {
            XB_SPIN(xb_ld(&bar[XB_XGEN(b.x)]) == gen, bar);
            __builtin_amdgcn_fence(__ATOMIC_ACQUIRE, "agent");
            asm volatile("s_waitcnt vmcnt(0)" ::: "memory");
        }
    }
    __syncthreads();
}


constexpr int NPHASE = 17;
#ifndef KSEL
#define KSEL 0x1ff
#endif
#define KON(k) (((KSEL) >> (k)) & 1)
#ifndef DUP_MASK
#define DUP_MASK 0
#endif
__global__ __launch_bounds__(512) void mega(P p) {
    extern __shared__ __attribute__((aligned(16))) unsigned char shm[];
    cg::grid_group grid = cg::this_grid();
    bf16_t* h16 = (bf16_t*)(p.ws + WS_H16); bf16_t* r1 = (bf16_t*)(p.ws + WS_R1); bf16_t* mix = (bf16_t*)(p.ws + WS_MIX);
    float* side = (float*)(p.ws + WS_SIDE);
    unsigned* ctl = (unsigned*)(p.ws + WS_CTL);
    volatile LAS unsigned* xst = (volatile LAS unsigned*)(shm + LDS_BYTES - 16);
    if (threadIdx.x == 0) { xst[0] = 0u; xst[1] = 0u; }
    __syncthreads();
    XcdBarrier xbar = xcd_barrier_post(ctl, xst);
    int nsync = 0;
#ifdef SYNC_EXTRA
    for (int i = 0; i < SYNC_EXTRA; ++i) xcd_barrier(xbar);
#endif
#pragma unroll 1
    for (int phx = p.ph_lo * 2; phx < p.ph_hi * 2; ++phx) {
        const int ph = phx >> 1, rep = phx & 1;
        if (rep && !((DUP_MASK >> ph) & 1)) continue;
        int kind = 0;
        pg8::Gemm g{}; bf16_t* O = nullptr; int ldc = 0, act = 0; const float* lg = nullptr; const float* lb = nullptr; int fin = 0; bf16_t* Y = nullptr; int sl = 0, sh = 0, nk = 0;
        g.M = MROWS; g.K = 1024; g.xonly = 0; g.lda = 1024; g.ldb = 1024;
        switch (ph) {
            case 0: kind = 4; break;
            case 1: kind = 1; g.A = h16; g.Bt = (const bf16_t*)(p.ws + WS_WAB); g.N = N0; O = r1; ldc = N0; sl = 6; sh = 8; break;
            case 2: kind = 5; break;
            case 3: kind = 6; break;
            case 4: kind = 2; g.A = mix; g.Bt = (const bf16_t*)(p.ws + WS_WABO); g.N = 1024; Y = r1; g.M = TAIL0; nk = 4; break;
            case 5: kind = 3; lg = p.in[12]; lb = p.in[13]; Y = r1; nk = 4; break;
            case 6: kind = 1; g.A = h16; g.Bt = (const bf16_t*)(p.ws + WS_W1); g.N = 4096; O = r1; ldc = LD1; act = 1; break;
            case 7: kind = 2; g.A = r1; g.Bt = (const bf16_t*)(p.ws + WS_W2); g.N = 1024; g.K = 4096; g.lda = LD1; g.ldb = 4096; Y = mix; g.M = TAIL0; nk = 16; break;
            case 8: kind = 3; lg = p.in[16]; lb = p.in[17]; Y = mix; nk = 16; break;
            case 9: kind = 1; g.A = h16; g.Bt = (const bf16_t*)(p.ws + WS_WC); g.N = N1; O = r1; ldc = LD1; sl = 12; sh = 16; break;
            case 10: kind = 7; break;
            case 11: kind = 8; break;
            case 12: kind = 2; g.A = mix; g.Bt = (const bf16_t*)(p.ws + WS_WCO); g.N = 1024; Y = r1; g.M = NB * SEQ; g.xonly = 1; break;
            case 13: kind = 3; lg = p.in[12] + 1024; lb = p.in[13] + 1024; Y = r1; g.xonly = 1; break;
            case 14: kind = 1; g.A = h16; g.Bt = (const bf16_t*)(p.ws + WS_W1) + (size_t)4096 * 1024; g.N = 4096; O = r1; ldc = LD1; act = 1; g.M = NB * SEQ; g.xonly = 1; break;
            case 15: kind = 2; g.A = r1; g.Bt = (const bf16_t*)(p.ws + WS_W2) + (size_t)4096 * 1024; g.N = 1024; g.K = 4096; g.lda = LD1; g.ldb = 4096; Y = mix; g.M = NB * SEQ; g.xonly = 1; break;
            default: kind = 3; lg = p.in[16] + 1024; lb = p.in[17] + 1024; fin = 1; Y = mix; g.xonly = 1; break;
        }
        if (KON(1) && kind == 1) {
            pg8::StaticOrder S; S.init(g.M, g.N, (int)gridDim.x, (int)blockIdx.x);
            EpiStore E{O, ldc, act, g.xonly, sl, sh};
            pg8::gemm_phase<EpiStore, pg8::StaticOrder, false>((PG8_LAS unsigned char*)shm, g, S, E, nullptr);
        } else if (KON(2) && kind == 2) {
            pg8::StaticOrder S; S.init(g.M, g.N, (int)gridDim.x, (int)blockIdx.x);
            EpiResid E{h16, Y, g.xonly};
            pg8::gemm_phase<EpiResid, pg8::StaticOrder, false>((PG8_LAS unsigned char*)shm, g, S, E, nullptr);
            if (nk > 0) {
                pg8::Gemm gt = g; gt.K = 256;
                pg8::TailOrder T; T.npieces = 16 * nk; T.nk = nk; T.pm0 = TAIL0 / 256; T.G = (int)gridDim.x; T.c = (int)blockIdx.x;
                EpiPart EP{p.out, TAIL0};
                pg8::gemm_phase<EpiPart, pg8::TailOrder, false>((PG8_LAS unsigned char*)shm, gt, T, EP, nullptr);
            }
        } else if (KON(3) && kind == 3) {
            ln_phase(p, Y, lg, lb, g.xonly, fin, nk);
        } else if (KON(4) && kind == 4) {
            prep_phase(p, shm, 0, (int)blockIdx.x, (int)gridDim.x);
        } else if (KON(5) && kind == 5) {
            for (int it = blockIdx.x; it < NB * 4 * NCH; it += gridDim.x) gdn_prep_item(p, it, shm);
        } else if (KON(6) && kind == 6) {
#ifdef PROBE2
            const unsigned long long q0 = __builtin_amdgcn_s_memrealtime();
#endif
            for (int ch = blockIdx.x; ch < NB * 4; ch += gridDim.x) scan_chain<0>(p, ch, shm);
#ifdef PROBE2
            const unsigned long long q1 = __builtin_amdgcn_s_memrealtime();
#endif
            const int tid = my_tid();
            bf16_t* vT = (bf16_t*)shm + (tid >> 6) * (64 * 36);
            for (;;) {
                int it = 0;
                if ((tid & 63) == 0) it = (int)atomicAdd(ctl + rep, 1u);
                it = __builtin_amdgcn_readfirstlane(it);
                if (it >= SB_ITEMS) break;
                sb_item(p, it, vT, tid & 63);
            }
            __syncthreads();
            { int bid = blockIdx.x, gsz = gridDim.x; asm volatile("" : "+s"(bid), "+s"(gsz));
              if (rep == 0) { if (gsz > NB * 4) { if (bid >= NB * 4) prep_phase(p, shm, 1, bid - NB * 4, gsz - NB * 4); } else prep_phase(p, shm, 1, bid, gsz); } }
#ifdef PROBE2
            { const unsigned long long q2 = __builtin_amdgcn_s_memrealtime();
              if (rep == 0 && threadIdx.x == 0 && (int)blockIdx.x == ((PROBE2 == 1) ? 0 : 255) && PROBE2 < 3) ctl[96] = (unsigned)((PROBE2 == 1) ? (q1 - q0) : (q2 - q0)); }
#endif
        } else if (KON(7) && kind == 7) {
            { const int tid = my_tid(); HgIn hin;
              { const float* lbr = p.in[9]; float* lbs = (float*)(shm + 36864);
                for (int i = tid; i < 1024; i += 512) lbs[i] = sigmoidf_(lbr[1024 + i] - lbr[i]);
                __syncthreads(); }
              hin.i8a = hin.i8b = hin.q8a = hin.q8b = hin.f8a = hin.f8b = (u32x4){0u, 0u, 0u, 0u};
              int it = blockIdx.x;
              if (it < NB * 8 * NCH) hg_prep_load(p, it, tid, hin);
              for (; it < NB * 8 * NCH; it += gridDim.x) { const int nx = it + (int)gridDim.x; hg_prep_item(p, it, nx < NB * 8 * NCH ? nx : -1, shm, tid, hin); } }
        } else if (KON(8) && kind == 8) {
#if defined(PROBE2) && PROBE2 == 3
            const unsigned long long q0 = __builtin_amdgcn_s_memrealtime();
#endif
            for (int ch = blockIdx.x; ch < NB * 8; ch += gridDim.x) scan_chain<1>(p, ch, shm);
#if defined(PROBE2) && PROBE2 == 3
            if (rep == 0 && threadIdx.x == 0 && blockIdx.x == 0) ctl[96] = (unsigned)(__builtin_amdgcn_s_memrealtime() - q0);
#endif
            { int bid = blockIdx.x, gsz = gridDim.x; asm volatile("" : "+s"(bid), "+s"(gsz));
              if (rep == 0) { if (gsz > NB * 8) { if (bid >= NB * 8) prep_phase(p, shm, 2, bid - NB * 8, gsz - NB * 8); } else prep_phase(p, shm, 2, bid, gsz); } }
        }
        if (!(ph == p.ph_hi - 1 && rep == ((DUP_MASK >> ph) & 1))) { if (nsync == 0) grid.sync(); else xcd_barrier(xbar); ++nsync; }
    }
#ifdef PROBE3
    if (threadIdx.x == 0 && blockIdx.x == 0) {
        const unsigned long long t = (unsigned long long)ctl[96] * 2ull, ps = __builtin_amdgcn_s_memrealtime();
        while (__builtin_amdgcn_s_memrealtime() - ps < t) __builtin_amdgcn_s_sleep(8);
    }
#endif
#ifdef PROBE2
    if (threadIdx.x == 0 && (int)blockIdx.x == ((PROBE2 == 2) ? 255 : 0)) {
        const unsigned long long t = (unsigned long long)ctl[96] * 2ull, ps = __builtin_amdgcn_s_memrealtime();
        while (__builtin_amdgcn_s_memrealtime() - ps < t) __builtin_amdgcn_s_sleep(8);
    }
#endif
}

extern "C" void kernel_launch(void* const* d_in, const int* in_sizes, int n_in, void* d_out, int out_size, void* d_ws, size_t ws_size, hipStream_t stream) {
    static int grid = 0;
    if (grid == 0) {
        if (n_in != 18 || out_size != NB * SEQ * DM || ws_size < WS_END) { fprintf(stderr, "kernel_launch: unexpected shapes (n_in %d out %d ws %zu need %zu)\n", n_in, out_size, ws_size, (size_t)WS_END); grid = -1; return; }
        int dev = 0, cus = 0, per_cu = 0;
        hipGetDevice(&dev);
        hipDeviceGetAttribute(&cus, hipDeviceAttributeMultiprocessorCount, dev);
        if (hipFuncSetAttribute((const void*)mega, hipFuncAttributeMaxDynamicSharedMemorySize, LDS_BYTES) != hipSuccess) { fprintf(stderr, "kernel_launch: hipFuncSetAttribute failed\n"); grid = -1; return; }
        hipOccupancyMaxActiveBlocksPerMultiprocessor(&per_cu, (const void*)mega, 512, LDS_BYTES);
        if (per_cu < 1) { fprintf(stderr, "kernel_launch: occupancy query says %d blocks per CU\n", per_cu); per_cu = 1; }
        (void)hipGetLastError();
        grid = cus;
    }
    if (grid < 0) return;
    hipMemsetAsync((unsigned char*)d_ws + WS_CTL, 0, 16384, stream);
    P p{};
    for (int i = 0; i < 18; ++i) p.in[i] = (const float*)d_in[i];
    p.out = (float*)d_out; p.ws = (unsigned char*)d_ws;
#ifndef MK_MULTI
    p.ph_lo = 0; p.ph_hi = NPHASE;
    void* args[] = {&p};
    hipError_t e = hipLaunchCooperativeKernel((const void*)mega, dim3(grid), dim3(512), args, LDS_BYTES, stream);
    if (e != hipSuccess) fprintf(stderr, "cooperative launch failed: %s (grid %d)\n", hipGetErrorString(e), grid);
#else
    for (int ph = 0; ph < NPHASE; ++ph) { p.ph_lo = ph; p.ph_hi = ph + 1; hipLaunchKernelGGL(mega, dim3(grid), dim3(512), LDS_BYTES, stream, p); }
#endif
}
```

```cpp
#include <hip/hip_runtime.h>
#include <hip/hip_cooperative_groups.h>
#include <cstdio>
namespace cg = cooperative_groups;
namespace pg8 {
#define PG8_LAS __attribute__((address_space(3)))
typedef unsigned short bf16_t;
typedef short bf16x8 __attribute__((ext_vector_type(8)));
typedef float f32x4 __attribute__((ext_vector_type(4)));
typedef unsigned u32x4 __attribute__((ext_vector_type(4)));
constexpr int BM = 256, BK = 64, HALF = 128, HTB = HALF * BK * 2  , STAGE_BYTES = 8 * HTB, NXCD = 8, WGM = 8;

__host__ __device__ __forceinline__ int lds_byte(int r, int c) { const int st = (r >> 4) * 2 + (c >> 5), rr = r & 15, cc = c & 31, ob = rr * 64 + cc * 2; return st * 1024 + (ob ^ (((ob >> 9) & 1) << 5)); }
__host__ __device__ __forceinline__ void stage_rc(int b, int& R, int& C) { const int st = b / 1024, sb = b % 1024, swz = sb ^ (((sb >> 9) & 1) << 5); R = (st >> 1) * 16 + swz / 64; C = (st & 1) * 32 + (swz % 64) / 2; }
__host__ __device__ __forceinline__ int perm32(int rho) { const int n = rho >> 4, i = rho & 15; return 8 * (i >> 2) + 4 * n + (i & 3); }

struct Unit { int pm, pn, kp; };
struct Gemm { const bf16_t* A; const bf16_t* Bt; int M, N, K, xonly, lda, ldb; };
__host__ __device__ __forceinline__ int rowbase(int pm, int xonly) { return xonly ? (pm >> 4) * 4224 + 128 + (pm & 15) * 256 : pm * 256; }

struct StaticOrder {
    int nM, nN, nwg, G, c;
    __host__ __device__ void init(int M, int N, int G_, int c_) { nM = M / BM; nN = N / BM; nwg = nM * nN; G = G_; c = c_; }
    __host__ __device__ bool next(int i, Unit& u) const {
        const long L = (long)i * G + c; if (L >= nwg) return false;
        int wgid = (int)L; { const int q = nwg / NXCD, r = nwg % NXCD, xcd = wgid % NXCD, off = wgid / NXCD; wgid = (xcd < r ? xcd * (q + 1) : r * (q + 1) + (xcd - r) * q) + off; }
        const int nig = WGM * nN, gid = wgid / nig, fm = gid * WGM, gsz = (nM - fm) < WGM ? (nM - fm) : WGM;
        u.pm = fm + ((wgid % nig) % gsz); u.pn = (wgid % nig) / gsz; u.kp = 0; return true;
    }
    __device__ __forceinline__ void a_ready(const Unit&) const {}
    __device__ __forceinline__ void done(const Unit&) const {}
};
struct TailOrder {
    int npieces, nk, pm0, G, c;
    __device__ __forceinline__ bool next(int i, Unit& u) const { const int L = i * G + c; if (L >= npieces) return false; const int tile = L / nk; u.kp = L - tile * nk; u.pm = pm0 + (tile >> 2); u.pn = tile & 3; return true; }
    __device__ __forceinline__ void a_ready(const Unit&) const {}
    __device__ __forceinline__ void done(const Unit&) const {}
};
template <class Epi, class Sched, bool STAMP = false>
__device__ __forceinline__ void gemm_phase(PG8_LAS unsigned char* lds, const Gemm g, const Sched& S, const Epi& E, unsigned long long* stamps) {
    int tid_ = threadIdx.x; asm volatile("" : "+v"(tid_)); const int tid = tid_, wid = __builtin_amdgcn_readfirstlane(tid >> 6), lane = tid & 63, wr = wid >> 2, wc = wid & 3, fr = lane & 15, fq = lane >> 4;
    const int K = g.K, nt = K / BK;
    int ts_lo = 0, ts_hi = 0, nts = 0; const unsigned long long rt_entry = STAMP ? (unsigned long long)wall_clock64() : 0ull;
#define PG8_STAMP() do { if (STAMP && wid == 0 && nts < 64) { const unsigned long long _c = (unsigned long long)clock64(); \
        ts_lo = (lane == nts) ? (int)(unsigned)_c : ts_lo; ts_hi = (lane == nts) ? (int)(unsigned)(_c >> 32) : ts_hi; ++nts; } } while (0)
    PG8_STAMP();
    unsigned voffA[2], voffB[2];
#pragma unroll
    for (int i = 0; i < 2; ++i) { int R, C; stage_rc(tid * 16 + i * 8192, R, C); const int Rb = Epi::PERM ? ((R & ~31) + perm32(R & 31)) : R;
        voffA[i] = (unsigned)(R * g.lda + C) * 2u; voffB[i] = (unsigned)(Rb * g.ldb + C) * 2u; }
    const size_t kstep = (size_t)(BK * 2);
    const size_t hstep = (size_t)HALF * g.ldb * 2;
    const size_t tstep = 2 * hstep;
    const size_t hstepA = (size_t)HALF * g.lda * 2;
    const unsigned ldsw = (unsigned)wid * 1024u;
    const int aoff = lds_byte(wr * 64 + fr, fq * 8), boff = lds_byte(wc * 32 + fr, fq * 8);
#define PG8_SA(b, h) (((b) * 2 + (h)) * HTB)
#define PG8_SB(b, h) ((4 + (b) * 2 + (h)) * HTB)
#define PG8_STAGE(bufoff, gbase, voff) do { _Pragma("unroll") for (int _i = 0; _i < 2; ++_i) \
        __builtin_amdgcn_global_load_lds((const unsigned*)((const char*)(gbase) + (voff)[_i]), (PG8_LAS unsigned*)(lds + (bufoff) + ldsw + _i * 8192), 16, 0, 0); } while (0)
#define PG8_LDA(dst, b, h) do { _Pragma("unroll") for (int m = 0; m < 4; ++m) _Pragma("unroll") for (int k = 0; k < 2; ++k) dst[m][k] = *(const PG8_LAS bf16x8*)(lds + PG8_SA(b, h) + aoff + m * 2048 + k * 1024); } while (0)
#define PG8_LDB(dst, b, h) do { _Pragma("unroll") for (int n = 0; n < 2; ++n) _Pragma("unroll") for (int k = 0; k < 2; ++k) dst[n][k] = *(const PG8_LAS bf16x8*)(lds + PG8_SB(b, h) + boff + n * 2048 + k * 1024); } while (0)
#define PG8_MMA(ai, bj, At, Bt) do { __builtin_amdgcn_s_setprio(1); _Pragma("unroll") for (int m = 0; m < 4; ++m) _Pragma("unroll") for (int n = 0; n < 2; ++n) _Pragma("unroll") for (int k = 0; k < 2; ++k) \
        acc[ai][bj][m][n] = __builtin_amdgcn_mfma_f32_16x16x32_bf16(Bt[n][k], At[m][k], acc[ai][bj][m][n], 0, 0, 0); __builtin_amdgcn_s_setprio(0); } while (0)
#define PG8_WAIT_V(n) asm volatile("s_waitcnt vmcnt(" #n ")" ::: "memory")
#define PG8_WAIT_L(n) asm volatile("s_waitcnt lgkmcnt(" #n ")" ::: "memory")
#define PG8_BAR __builtin_amdgcn_s_barrier()
#define PG8_SCHED __builtin_amdgcn_sched_barrier(0)
    Unit cur, nxt; int ui = 0;
    if (!S.next(0, cur)) return;
    f32x4 acc[2][2][4][2];
#pragma unroll
    for (int a = 0; a < 2; ++a)
#pragma unroll
        for (int b = 0; b < 2; ++b)
#pragma unroll
            for (int m = 0; m < 4; ++m)
#pragma unroll
                for (int n = 0; n < 2; ++n) acc[a][b][m][n] = (f32x4){0.f, 0.f, 0.f, 0.f};
    bf16x8 At[4][2], B0[2][2], B1[2][2];
    const size_t rstep = (size_t)g.lda * 2;
    const char* cA = (const char*)g.A + (size_t)rowbase(cur.pm, g.xonly) * rstep + (size_t)cur.kp * K * 2; const char* cB = (const char*)g.Bt + (size_t)cur.pn * tstep + (size_t)cur.kp * K * 2;
    S.a_ready(cur);
    PG8_STAGE(PG8_SB(0, 0), cB, voffB); PG8_STAGE(PG8_SA(0, 0), cA, voffA); PG8_STAGE(PG8_SB(0, 1), cB + hstep, voffB); PG8_STAGE(PG8_SA(0, 1), cA + hstepA, voffA);
    if (wr == 1) PG8_BAR;
    PG8_WAIT_V(4); PG8_BAR;
    PG8_STAGE(PG8_SB(1, 0), cB + kstep, voffB); PG8_STAGE(PG8_SA(1, 0), cA + kstep, voffA); PG8_STAGE(PG8_SB(1, 1), cB + hstep + kstep, voffB);
    PG8_WAIT_V(6); PG8_BAR;
    PG8_STAMP();
    for (;;) {
        const bool has_next = S.next(ui + 1, nxt);
        const char* nA = has_next ? (const char*)g.A + (size_t)rowbase(nxt.pm, g.xonly) * rstep + (size_t)nxt.kp * K * 2 : cA; const char* nB = has_next ? (const char*)g.Bt + (size_t)nxt.pn * tstep + (size_t)nxt.kp * K * 2 : cB;
        for (int t = 0; t < nt; t += 2) {
            const bool last = (t == nt - 2);
            const char* a1 = cA + (size_t)(t + 1) * kstep;
            const char* a2 = last ? nA : cA + (size_t)(t + 2) * kstep; const char* b2 = last ? nB : cB + (size_t)(t + 2) * kstep;
            const char* a3 = a2 + kstep; const char* b3 = b2 + kstep;
            if (last && has_next) S.a_ready(nxt);
            PG8_LDB(B0, 0, 0); PG8_SCHED; PG8_LDA(At, 0, 0); PG8_STAGE(PG8_SA(1, 1), a1 + hstepA, voffA);
            PG8_WAIT_L(8); PG8_BAR; PG8_WAIT_L(0); PG8_MMA(0, 0, At, B0); PG8_BAR; PG8_SCHED;
            PG8_LDB(B1, 0, 1); PG8_STAGE(PG8_SB(0, 0), b2, voffB);
            PG8_BAR; PG8_WAIT_L(0); PG8_MMA(0, 1, At, B1); PG8_BAR;
            PG8_LDA(At, 0, 1); PG8_STAGE(PG8_SA(0, 0), a2, voffA);
            PG8_BAR; PG8_WAIT_L(0); PG8_MMA(1, 0, At, B0); PG8_BAR; PG8_SCHED;
            PG8_STAGE(PG8_SB(0, 1), b2 + hstep, voffB);
            PG8_WAIT_V(6); PG8_BAR; PG8_MMA(1, 1, At, B1); PG8_BAR;
            PG8_LDB(B0, 1, 0); PG8_SCHED; PG8_LDA(At, 1, 0); PG8_STAGE(PG8_SA(0, 1), a2 + hstepA, voffA);
            PG8_WAIT_L(8); PG8_BAR; PG8_WAIT_L(0); PG8_MMA(0, 0, At, B0); PG8_BAR; PG8_SCHED;
            PG8_LDB(B1, 1, 1); PG8_STAGE(PG8_SB(1, 0), b3, voffB);
            PG8_BAR; PG8_WAIT_L(0); PG8_MMA(0, 1, At, B1); PG8_BAR;
            PG8_LDA(At, 1, 1); PG8_STAGE(PG8_SA(1, 0), a3, voffA);
            PG8_BAR; PG8_WAIT_L(0); PG8_MMA(1, 0, At, B0); PG8_BAR; PG8_SCHED;
            PG8_STAGE(PG8_SB(1, 1), b3 + hstep, voffB);
            PG8_WAIT_V(6); PG8_BAR; PG8_MMA(1, 1, At, B1); PG8_BAR;
        }
        PG8_STAMP();
        if constexpr (!Epi::AFTER_DRAIN) { E(acc, cur, wr, wc, fr, fq); S.done(cur); }
        PG8_STAMP();
        if (!has_next) break;
#pragma unroll
        for (int a = 0; a < 2; ++a)
#pragma unroll
            for (int b = 0; b < 2; ++b)
#pragma unroll
                for (int m = 0; m < 4; ++m)
#pragma unroll
                    for (int n = 0; n < 2; ++n) acc[a][b][m][n] = (f32x4){0.f, 0.f, 0.f, 0.f};
        cur = nxt; cA = nA; cB = nB; ++ui;
    }
    PG8_WAIT_V(0);
    if (wr == 0) PG8_BAR;
    PG8_BAR;
    if constexpr (Epi::AFTER_DRAIN) { E.fused(acc, cur, wr, wc, fr, fq, lds, wid, lane); S.done(cur); }
    PG8_STAMP();
    if (STAMP && wid == 0) { stamps[lane] = lane < nts ? (((unsigned long long)(unsigned)ts_hi << 32) | (unsigned)ts_lo) : 0ull;
        if (lane == 62) stamps[62] = rt_entry; if (lane == 63) stamps[63] = (unsigned long long)wall_clock64(); }
#undef PG8_STAMP
#undef PG8_SA
#undef PG8_SB
#undef PG8_STAGE
#undef PG8_LDA
#undef PG8_LDB
#undef PG8_MMA
#undef PG8_WAIT_V
#undef PG8_WAIT_L
#undef PG8_BAR
#undef PG8_SCHED
}
}

using pg8::bf16_t; using pg8::bf16x8; using pg8::f32x4; using pg8::u32x4;
typedef float f32x16 __attribute__((ext_vector_type(16)));
typedef float f32x2v __attribute__((ext_vector_type(2)));
typedef __bf16 bf2v __attribute__((ext_vector_type(2)));
typedef unsigned u32x2 __attribute__((ext_vector_type(2)));
#define DI __device__ __forceinline__
#define MFMA32(a, b, c) __builtin_amdgcn_mfma_f32_32x32x16_bf16((a), (b), (c), 0, 0, 0)

constexpr int NB = 8, SEQ = 4096, PADF = 112, XOFF = 128, TT = 4224, MROWS = NB * TT, DM = 1024, DFF = 4096;
constexpr int N0 = 3840, N1 = 4096, LD1 = 4160, NCH = TT / 64;
constexpr float DN_ALPHA = 1.4142135623730951f;
constexpr int LDS_BYTES = 153600;
constexpr int SB_ITEMS = 129 * 64;
constexpr int TAIL0 = 32768;

constexpr size_t WS_CTL = 0;
constexpr size_t WS_WAB = 16384;
constexpr size_t WS_WABO = WS_WAB + (size_t)N0 * 1024 * 2;
constexpr size_t WS_WC = WS_WABO + (size_t)1024 * 1024 * 2;
constexpr size_t WS_WCO = WS_WC + (size_t)4096 * 1024 * 2;
constexpr size_t WS_W1 = WS_WCO + (size_t)1024 * 1024 * 2;
constexpr size_t WS_W2 = WS_W1 + (size_t)2 * 4096 * 1024 * 2;
constexpr size_t WS_H16 = WS_W2 + (size_t)2 * 4096 * 1024 * 2;
constexpr size_t WS_R1 = WS_H16 + (size_t)MROWS * 1024 * 2;
constexpr size_t WS_MIX = WS_R1 + (size_t)MROWS * LD1 * 2;
constexpr size_t WS_SIDE = WS_MIX + (size_t)MROWS * 1024 * 2;
constexpr size_t WS_KDT = WS_SIDE + (size_t)NB * 128 * 1024 * 4;
constexpr size_t WS_GA = WS_KDT + (size_t)MROWS * 512 * 2;
constexpr size_t WS_GT = WS_GA + (size_t)MROWS * 256 * 2;
constexpr size_t WS_END = WS_GT + 16384;
constexpr size_t DO_W = 0, DO_QD = (size_t)MROWS * 512 * 2, DO_UT = 2 * DO_QD;
constexpr size_t DO_HA = 0, DO_DVEC = (size_t)NB * 8 * NCH * 4096 * 2;

struct P { const float* in[18]; float* out; unsigned char* ws; int ph_lo, ph_hi; };

DI int my_tid() { int t = threadIdx.x; asm volatile("" : "+v"(t)); return t; }
DI float bf2f(unsigned short b) { return __uint_as_float(((unsigned)b) << 16); }
DI unsigned pack2(float lo, float hi) { f32x2v v = {lo, hi}; bf2v b = __builtin_convertvector(v, bf2v); return __builtin_bit_cast(unsigned, b); }
DI unsigned short f2bf(float x) { return (unsigned short)(pack2(x, 0.f) & 0xffffu); }
DI int crow(int reg, int h) { return (reg & 3) + 8 * (reg >> 2) + 4 * h; }
DI float sigmoidf_(float x) { return __builtin_amdgcn_rcpf(1.f + __expf(-x)); }
DI float siluf_(float x) { return x * __builtin_amdgcn_rcpf(1.f + __expf(-x)); }
DI float softplusf_(float x) { return fmaxf(x, 0.f) + __logf(1.f + __expf(-fabsf(x))); }
DI float lo16(unsigned u) { return __uint_as_float(u << 16); }
DI float hi16(unsigned u) { return __uint_as_float(u & 0xffff0000u); }
DI bf16x8 pack8(const f32x16& x, int s) {
    u32x4 p;
    p[0] = pack2(x[8 * s + 0], x[8 * s + 1]); p[1] = pack2(x[8 * s + 2], x[8 * s + 3]);
    p[2] = pack2(x[8 * s + 4], x[8 * s + 5]); p[3] = pack2(x[8 * s + 6], x[8 * s + 7]);
    return __builtin_bit_cast(bf16x8, p);
}
DI bf16x8 loadA(const bf16_t* p) {
    u32x2 a = *(const u32x2*)p, b = *(const u32x2*)(p + 8);
    u32x4 v = {a[0], a[1], b[0], b[1]};
    return __builtin_bit_cast(bf16x8, v);
}
DI float* yrow(float* dout, float* side, int row) {
    const int b = row / TT, pos = row - b * TT;
    return pos >= XOFF ? dout + ((size_t)b * SEQ + (pos - XOFF)) * DM : side + ((size_t)b * XOFF + pos) * DM;
}

struct EpiStore {
    static constexpr bool PERM = true, AFTER_DRAIN = false;
    bf16_t* O; int ldc; int act; int xonly; int sl, sh;
    DI void operator()(const f32x4 (&acc)[2][2][4][2], const pg8::Unit& u, int wr, int wc, int fr, int fq) const {
        const int row0 = pg8::rowbase(u.pm, xonly) + wr * 64 + fr, col0 = u.pn * 256 + wc * 32 + 8 * fq;
        const bool gate = u.pn >= sl && u.pn < sh;
#pragma unroll
        for (int ai = 0; ai < 2; ++ai)
#pragma unroll
            for (int m = 0; m < 4; ++m) {
                bf16_t* rowp = O + (size_t)(row0 + ai * 128 + m * 16) * ldc + col0;
#pragma unroll
                for (int bj = 0; bj < 2; ++bj) {
                    f32x4 v0 = acc[ai][bj][m][0], v1 = acc[ai][bj][m][1];
                    if (act) {
#pragma unroll
                        for (int e = 0; e < 4; ++e) { float a = fmaxf(v0[e], 0.f), b = fmaxf(v1[e], 0.f); v0[e] = a * a; v1[e] = b * b; }
                    }
                    if (gate) {
#pragma unroll
                        for (int e = 0; e < 4; ++e) { v0[e] = siluf_(v0[e]); v1[e] = siluf_(v1[e]); }
                    }
                    u32x4 o = {pack2(v0[0], v0[1]), pack2(v0[2], v0[3]), pack2(v1[0], v1[1]), pack2(v1[2], v1[3])};
                    __builtin_nontemporal_store(o, (u32x4*)(rowp + bj * 128));
                }
            }
    }
};
struct EpiResid {
    static constexpr bool PERM = true, AFTER_DRAIN = false;
    const bf16_t* H; bf16_t* Y; int xonly;
    DI void operator()(const f32x4 (&acc)[2][2][4][2], const pg8::Unit& u, int wr, int wc, int fr, int fq) const {
        const int row0 = pg8::rowbase(u.pm, xonly) + wr * 64 + fr, col0 = u.pn * 256 + wc * 32 + 8 * fq;
#pragma unroll
        for (int ai = 0; ai < 2; ++ai)
#pragma unroll
            for (int m = 0; m < 4; ++m) {
                const size_t ro = (size_t)(row0 + ai * 128 + m * 16) * DM + col0;
#pragma unroll
                for (int bj = 0; bj < 2; ++bj) {
                    const u32x4 hv = *(const u32x4*)(H + ro + bj * 128);
                    const f32x4 v0 = acc[ai][bj][m][0], v1 = acc[ai][bj][m][1];
                    u32x4 o = {pack2(DN_ALPHA * lo16(hv[0]) + v0[0], DN_ALPHA * hi16(hv[0]) + v0[1]), pack2(DN_ALPHA * lo16(hv[1]) + v0[2], DN_ALPHA * hi16(hv[1]) + v0[3]),
                               pack2(DN_ALPHA * lo16(hv[2]) + v1[0], DN_ALPHA * hi16(hv[2]) + v1[1]), pack2(DN_ALPHA * lo16(hv[3]) + v1[2], DN_ALPHA * hi16(hv[3]) + v1[3])};
                    *(u32x4*)(Y + ro + bj * 128) = o;
                }
            }
    }
};

struct EpiPart {
    static constexpr bool PERM = false, AFTER_DRAIN = false;
    float* slab; int row_origin;
    DI void operator()(const f32x4 (&acc)[2][2][4][2], const pg8::Unit& u, int wr, int wc, int fr, int fq) const {
        const int row0 = u.pm * 256 - row_origin + wr * 64 + fr, col0 = u.pn * 256 + wc * 32 + 4 * fq;
#pragma unroll
        for (int ai = 0; ai < 2; ++ai)
#pragma unroll
            for (int m = 0; m < 4; ++m) {
                float* rp = slab + ((size_t)u.kp * 1024 + (row0 + ai * 128 + m * 16)) * 1024 + col0;
#pragma unroll
                for (int bj = 0; bj < 2; ++bj)
#pragma unroll
                    for (int n = 0; n < 2; ++n) *(f32x4*)(rp + bj * 128 + n * 16) = acc[ai][bj][m][n];
            }
    }
};

DI void prep_phase(const P& p, unsigned char* lds, int part, int wid, int nwk) {
    float* tile = (float*)lds;
    const int tid = my_tid();
    constexpr int NT0 = 16 * 60, NT1 = 16 * 16, NT2 = 16 * 64, NT3 = 16 * 16, NT4 = 16 * 64, NT5 = 64 * 16;
    constexpr int C0 = NT0, C1 = C0 + NT1, C2 = C1 + NT2, C3 = C2 + NT3, C4 = C3 + 2 * NT4, C5 = C4 + 2 * NT5;
    const int npart = part == 0 ? C0 : (part == 1 ? (C2 - C0) + NT4 + NT5 : (C3 - C2) + NT4 + NT5);
    for (int j = wid; j < npart; j += nwk) {
        int tix;
        if (part == 0) tix = j;
        else if (part == 1) tix = j < (C2 - C0) ? C0 + j : (j < (C2 - C0) + NT4 ? C3 + (j - (C2 - C0)) : C4 + (j - (C2 - C0) - NT4));
        else tix = j < (C3 - C2) ? C2 + j : (j < (C3 - C2) + NT4 ? C3 + NT4 + (j - (C3 - C2)) : C4 + NT5 + (j - (C3 - C2) - NT4));
        const float* src; bf16_t* dst; int K, Ns, Nd, loc, remap = 0;
        if (tix < C0) { src = p.in[2]; dst = (bf16_t*)(p.ws + WS_WAB); K = 1024; Ns = 3592; Nd = N0; loc = tix; remap = 1; }
        else if (tix < C1) { src = p.in[7]; dst = (bf16_t*)(p.ws + WS_WABO); K = 1024; Ns = 1024; Nd = 1024; loc = tix - C0; }
        else if (tix < C2) { src = p.in[8]; dst = (bf16_t*)(p.ws + WS_WC); K = 1024; Ns = 4096; Nd = 4096; loc = tix - C1; }
        else if (tix < C3) { src = p.in[11]; dst = (bf16_t*)(p.ws + WS_WCO); K = 1024; Ns = 1024; Nd = 1024; loc = tix - C2; }
        else if (tix < C4) { int l = (tix - C3) / NT4; src = p.in[14] + (size_t)l * 1024 * 4096; dst = (bf16_t*)(p.ws + WS_W1) + (size_t)l * 4096 * 1024; K = 1024; Ns = 4096; Nd = 4096; loc = (tix - C3) % NT4; }
        else { int l = (tix - C4) / NT5; src = p.in[15] + (size_t)l * 4096 * 1024; dst = (bf16_t*)(p.ws + WS_W2) + (size_t)l * 1024 * 4096; K = 4096; Ns = 1024; Nd = 1024; loc = (tix - C4) % NT5; }
        const int ntn = Nd / 64, kt = loc / ntn, nt = loc % ntn, k0 = kt * 64, n0 = nt * 64;
#pragma unroll
        for (int it = 0; it < 2; ++it) {
            const int i = (tid >> 4) + 32 * it, j = (tid & 15) * 4, n = n0 + j;
            int ns = n; bool valid = true;
            if (remap) { if (n < 2048) ns = n; else if (n < 3584) ns = n + 8; else if (n < 3592) ns = n - 3584 + 2048; else valid = false; }
            f32x4 v = {0.f, 0.f, 0.f, 0.f};
            if (valid) v = *(const f32x4*)(src + (size_t)(k0 + i) * Ns + ns);
            tile[i * 65 + j] = v[0]; tile[i * 65 + j + 1] = v[1]; tile[i * 65 + j + 2] = v[2]; tile[i * 65 + j + 3] = v[3];
        }
        __syncthreads();
        {
            const int j = tid >> 3, i0 = (tid & 7) * 8;
            u32x4 o;
#pragma unroll
            for (int e = 0; e < 4; ++e) o[e] = pack2(tile[(i0 + 2 * e) * 65 + j], tile[(i0 + 2 * e + 1) * 65 + j]);
            *(u32x4*)(dst + (size_t)(n0 + j) * K + k0 + i0) = o;
        }
        __syncthreads();
    }
    if (part != 0) return;
    bf16_t* h16 = (bf16_t*)(p.ws + WS_H16);
    const float* x = p.in[0]; const float* meta = p.in[1];
    for (int uidx = blockIdx.x * 512 + tid; uidx < MROWS * 128; uidx += gridDim.x * 512) {
        const int row = uidx >> 7, c0 = (uidx & 127) * 8, b = row / TT, pos = row - b * TT;
        u32x4 o = {0u, 0u, 0u, 0u};
        if (pos >= PADF) {
            const float* s = pos >= XOFF ? x + ((size_t)b * SEQ + (pos - XOFF)) * DM + c0 : meta + (size_t)(pos - PADF) * DM + c0;
            const f32x4 a = *(const f32x4*)s, c = *(const f32x4*)(s + 4);
            o[0] = pack2(a[0], a[1]); o[1] = pack2(a[2], a[3]); o[2] = pack2(c[0], c[1]); o[3] = pack2(c[2], c[3]);
        }
        *(u32x4*)(h16 + (size_t)row * DM + c0) = o;
    }
}

DI float wave_sum(float v) {
#pragma unroll
    for (int o = 32; o >= 1; o >>= 1) v += __shfl_xor(v, o);
    return v;
}
DI void ln_phase(const P& p, const bf16_t* Y, const float* g, const float* bb, int xonly, int final_, int nk) {
    const int tid = my_tid(), lane = tid & 63, gw = blockIdx.x * 8 + (tid >> 6), nw = gridDim.x * 8;
    bf16_t* h16 = (bf16_t*)(p.ws + WS_H16);
    f32x4 gv[4], bv[4];
#pragma unroll
    for (int i = 0; i < 2; ++i) { gv[2 * i] = *(const f32x4*)(g + i * 512 + lane * 8); gv[2 * i + 1] = *(const f32x4*)(g + i * 512 + lane * 8 + 4);
                                  bv[2 * i] = *(const f32x4*)(bb + i * 512 + lane * 8); bv[2 * i + 1] = *(const f32x4*)(bb + i * 512 + lane * 8 + 4); }
    for (int row = gw; row < MROWS; row += nw) {
        const int b = row / TT, pos = row - b * TT;
        if (xonly && pos < XOFF) continue;
        const bf16_t* y = Y + (size_t)row * DM;
        float v[16]; float s = 0.f;
        if (nk > 0 && row >= TAIL0) {
#pragma unroll
            for (int i = 0; i < 2; ++i) {
                const u32x4 w = *(const u32x4*)(h16 + (size_t)row * DM + i * 512 + lane * 8);
#pragma unroll
                for (int e = 0; e < 4; ++e) { v[8 * i + 2 * e] = DN_ALPHA * lo16(w[e]); v[8 * i + 2 * e + 1] = DN_ALPHA * hi16(w[e]); }
            }
            for (int kp = 0; kp < nk; ++kp) {
                const float* sp = p.out + ((size_t)kp * 1024 + (row - TAIL0)) * 1024 + lane * 8;
#pragma unroll
                for (int i = 0; i < 2; ++i) {
                    const f32x4 a = *(const f32x4*)(sp + i * 512), c = *(const f32x4*)(sp + i * 512 + 4);
#pragma unroll
                    for (int e = 0; e < 4; ++e) { v[8 * i + e] += a[e]; v[8 * i + 4 + e] += c[e]; }
                }
            }
        } else {
#pragma unroll
            for (int i = 0; i < 2; ++i) {
                const u32x4 w = *(const u32x4*)(y + i * 512 + lane * 8);
#pragma unroll
                for (int e = 0; e < 4; ++e) { v[8 * i + 2 * e] = lo16(w[e]); v[8 * i + 2 * e + 1] = hi16(w[e]); }
            }
        }
#pragma unroll
        for (int e = 0; e < 16; ++e) s += v[e];
        const float mean = wave_sum(s) * (1.f / 1024.f);
        float q = 0.f;
#pragma unroll
        for (int e = 0; e < 16; ++e) { const float d = v[e] - mean; q += d * d; }
        const float rstd = rsqrtf(wave_sum(q) * (1.f / 1024.f) + 1e-5f);
        float o[16];
#pragma unroll
        for (int e = 0; e < 16; ++e) o[e] = (v[e] - mean) * rstd * gv[e >> 2][e & 3] + bv[e >> 2][e & 3];
        if (final_) {
            float* dst = p.out + ((size_t)b * SEQ + (pos - XOFF)) * DM;
#pragma unroll
            for (int i = 0; i < 2; ++i) { *(f32x4*)(dst + i * 512 + lane * 8) = (f32x4){o[8 * i], o[8 * i + 1], o[8 * i + 2], o[8 * i + 3]};
                                          *(f32x4*)(dst + i * 512 + lane * 8 + 4) = (f32x4){o[8 * i + 4], o[8 * i + 5], o[8 * i + 6], o[8 * i + 7]}; }
        } else {
#pragma unroll
            for (int i = 0; i < 2; ++i) {
                u32x4 w = {pack2(o[8 * i], o[8 * i + 1]), pack2(o[8 * i + 2], o[8 * i + 3]), pack2(o[8 * i + 4], o[8 * i + 5]), pack2(o[8 * i + 6], o[8 * i + 7])};
                if (pos < PADF) w = (u32x4){0u, 0u, 0u, 0u};
                *(u32x4*)(h16 + (size_t)row * DM + i * 512 + lane * 8) = w;
            }
        }
    }
}

DI void gdn_prep_item(const P& p, int item, unsigned char* lds) {
#ifdef PROBE3
    unsigned long long p3t = __builtin_amdgcn_s_memrealtime(), p3acc = 0ull;
#endif
    const int tid = my_tid(), lane = tid & 63, wv = tid >> 6, r = lane & 31, hh = lane >> 5;
    const int n = item % NCH, hb = item / NCH, h = hb & 3, b = hb >> 2;
    const int row0 = b * TT + n * 64;
    const bf16_t* proj = (const bf16_t*)(p.ws + WS_R1);
    bf16_t* qs = (bf16_t*)lds;
    bf16_t* ks = qs + 64 * 136;
    bf16_t* vbT = ks + 64 * 136;
    bf16_t* kbT = vbT + 128 * 72;
    bf16_t* kdTs = kbT + 128 * 72;
    bf16_t* Tm = kdTs + 128 * 72;
    float* Mm = (float*)(Tm + 64 * 72);
    float* gcs = Mm + 64 * 64; float* betas = gcs + 64;
    float* fac = (float*)(lds + 137216);
    bf16_t* Wg = (bf16_t*)((unsigned char*)p.out + DO_W); bf16_t* QD = (bf16_t*)((unsigned char*)p.out + DO_QD); bf16_t* UT = (bf16_t*)((unsigned char*)p.out + DO_UT);
    bf16_t* KDT = (bf16_t*)(p.ws + WS_KDT); bf16_t* GA = (bf16_t*)(p.ws + WS_GA); float* GT = (float*)(p.ws + WS_GT);
    const float* conv_w = p.in[3];
    bf16_t* vs = Tm;
    {
        const int seg = tid / 48, g48 = tid - seg * 48, part = g48 >> 4, c0 = (g48 & 15) * 8;
        const int ch = part * 512 + h * 128 + c0, pos0 = n * 64 + seg * 8;
        if (tid < 384) {
            u32x4 xr[11]; f32x4 wg[8];
#pragma unroll
            for (int j = 0; j < 11; ++j) {
                const int pp = pos0 - 3 + j;
                xr[j] = (u32x4){0u, 0u, 0u, 0u};
                if (pp >= 0) xr[j] = *(const u32x4*)(proj + (size_t)(b * TT + pp) * N0 + ch);
            }
#pragma unroll
            for (int k = 0; k < 4; ++k) { wg[2 * k] = *(const f32x4*)(conv_w + k * 1536 + ch); wg[2 * k + 1] = *(const f32x4*)(conv_w + k * 1536 + ch + 4); }
            bf16_t* dst = (part == 0 ? qs : (part == 1 ? ks : vs)) + c0;
#pragma unroll
            for (int tt = 0; tt < 8; ++tt) {
                float acc[8];
#pragma unroll
                for (int e = 0; e < 8; ++e) acc[e] = 0.f;
#pragma unroll
                for (int k = 0; k < 4; ++k) {
                    const u32x4 xv = xr[tt + k]; const f32x4 w0 = wg[2 * k], w1 = wg[2 * k + 1];
                    acc[0] += w0[0] * lo16(xv[0]); acc[1] += w0[1] * hi16(xv[0]); acc[2] += w0[2] * lo16(xv[1]); acc[3] += w0[3] * hi16(xv[1]);
                    acc[4] += w1[0] * lo16(xv[2]); acc[5] += w1[1] * hi16(xv[2]); acc[6] += w1[2] * lo16(xv[3]); acc[7] += w1[3] * hi16(xv[3]);
                }
                float ss = 0.f;
#pragma unroll
                for (int e = 0; e < 8; ++e) { acc[e] = siluf_(acc[e]); ss += acc[e] * acc[e]; }
                ss += __shfl_xor(ss, 1); ss += __shfl_xor(ss, 2); ss += __shfl_xor(ss, 4); ss += __shfl_xor(ss, 8);
                const float sc = part == 2 ? 1.f : rsqrtf(ss + 1e-6f) * (part == 0 ? 0.08838834764831845f : 1.f);
                u32x4 o = {pack2(acc[0] * sc, acc[1] * sc), pack2(acc[2] * sc, acc[3] * sc), pack2(acc[4] * sc, acc[5] * sc), pack2(acc[6] * sc, acc[7] * sc)};
                *(u32x4*)(dst + (seg * 8 + tt) * 136) = o;
            }
        } else if (tid >= 448) {
            const int t = tid - 448;
            const size_t ro = (size_t)(row0 + t) * N0;
            const float ba = bf2f(proj[ro + 3584 + h]), aa = bf2f(proj[ro + 3588 + h]);
            const float beta = sigmoidf_(ba);
            float g = -__expf(p.in[4][h]) * softplusf_(aa + p.in[5][h]);
#pragma unroll
            for (int o = 1; o < 64; o <<= 1) { const float tv = __shfl_up(g, o); if (lane >= o) g += tv; }
            gcs[t] = g; betas[t] = beta;
            const float glw = __builtin_bit_cast(float, __builtin_amdgcn_readlane(__builtin_bit_cast(int, g), 63)), eg = __expf(g);
            fac[t] = eg; fac[64 + t] = beta * eg; fac[128 + t] = __expf(glw - g);
        }
    }
    __syncthreads();
    const float gl = gcs[63];
    if (tid == 0) GT[item] = __expf(gl);
#pragma unroll
    for (int it = 0; it < 2; ++it) {
        const int idx = it * 512 + tid, t = idx >> 4, c8 = (idx & 15) * 8;
        const u32x4 q8 = *(const u32x4*)(qs + t * 136 + c8);
        const float eg = fac[t];
        u32x4 o2 = {pack2(lo16(q8[0]) * eg, hi16(q8[0]) * eg), pack2(lo16(q8[1]) * eg, hi16(q8[1]) * eg), pack2(lo16(q8[2]) * eg, hi16(q8[2]) * eg), pack2(lo16(q8[3]) * eg, hi16(q8[3]) * eg)};
        *(u32x4*)(QD + (size_t)(row0 + t) * 512 + h * 128 + c8) = o2;
    }
#pragma unroll
    for (int it = 0; it < 6; ++it) {
        const int u = it * 512 + tid, arr = u >> 10, rem = u & 1023, c = rem & 127, t8 = (rem >> 7) * 8;
        const bf16_t* src = (arr < 2 ? ks : vs) + c;
        bf16_t* dstT = (arr == 0 ? kbT : (arr == 1 ? kdTs : vbT)) + c * 72 + t8;
        float v[8];
#pragma unroll
        for (int j = 0; j < 8; ++j) {
            const float f = arr == 0 ? fac[64 + t8 + j] : (arr == 1 ? fac[128 + t8 + j] : betas[t8 + j]);
            v[j] = bf2f(src[(t8 + j) * 136]) * f;
        }
        u32x4 o = {pack2(v[0], v[1]), pack2(v[2], v[3]), pack2(v[4], v[5]), pack2(v[6], v[7])};
        *(u32x4*)dstT = o;
    }
    __syncthreads();
    {
        const int which = wv >> 2, mi = (wv >> 1) & 1, ni = wv & 1;
        const bf16_t* Ap = (which ? qs : ks) + (32 * mi + r) * 136 + 8 * hh;
        const bf16_t* Bp = ks + (32 * ni + r) * 136 + 8 * hh;
        f32x16 acc;
#pragma unroll
        for (int j = 0; j < 16; ++j) acc[j] = 0.f;
#pragma unroll
        for (int s = 0; s < 8; ++s) acc = MFMA32(*(const bf16x8*)(Ap + 16 * s), *(const bf16x8*)(Bp + 16 * s), acc);
        const int jt = 32 * ni + r; const float gj = gcs[jt];
#pragma unroll
        for (int j = 0; j < 16; ++j) {
            const int i = 32 * mi + crow(j, hh);
            const float dec = __expf(fminf(gcs[i] - gj, 0.f));
            if (which == 0) Mm[i * 64 + jt] = (jt < i) ? betas[i] * acc[j] * dec : 0.f;
            else GA[(size_t)item * 4096 + i * 64 + jt] = f2bf((jt <= i) ? acc[j] * dec : 0.f);
        }
    }
    __syncthreads();
#ifdef PROBE3
    { const unsigned long long tq = __builtin_amdgcn_s_memrealtime(); if (PROBE3 == 3) p3acc += tq - p3t; p3t = tq; }
#endif
    float* Tf = (float*)(lds + 116224);
    float* Xs = Tf + 4096;
    if (wv == 0) {
        const int d = lane >> 5, c = lane & 31;
        const float* Mb = Mm + (32 * d) * 64 + 32 * d;
        float x[32];
        f32x4 mc[8], mn[8];
#pragma unroll
        for (int q = 0; q < 8; ++q) { mc[q] = (f32x4){0.f, 0.f, 0.f, 0.f}; mn[q] = mc[q]; }
#pragma unroll
        for (int i = 0; i < 32; ++i) {
            if (i + 1 < 32) {
#pragma unroll
                for (int q = 0; q < (i + 4) / 4; ++q) mn[q] = *(const f32x4*)(Mb + (i + 1) * 64 + 4 * q);
            }
            __builtin_amdgcn_sched_barrier(0);
            float a0 = (i == c) ? 1.f : 0.f, a1 = 0.f;
#pragma unroll
            for (int l = 0; l < i; ++l) { if (l & 1) a1 -= mc[l >> 2][l & 3] * x[l]; else a0 -= mc[l >> 2][l & 3] * x[l]; }
            x[i] = a0 + a1;
            __builtin_amdgcn_sched_barrier(0);
#pragma unroll
            for (int q = 0; q < 8; ++q) mc[q] = mn[q];
        }
#pragma unroll
        for (int i = 0; i < 32; ++i) Tf[(32 * d + i) * 64 + 32 * d + c] = x[i];
        if (d == 0) {
#pragma unroll
            for (int i = 0; i < 32; ++i) Tf[i * 64 + 32 + c] = 0.f;
        }
    }
    __syncthreads();
#ifdef PROBE3
    { const unsigned long long tq = __builtin_amdgcn_s_memrealtime(); if (PROBE3 == 4) p3acc += tq - p3t; p3t = tq; }
#endif
    {
        const int i = tid >> 4, j0 = (tid & 15) * 2;
        float x0 = 0.f, x1 = 0.f;
#pragma unroll
        for (int q = 0; q < 8; ++q) {
            const f32x4 m = *(const f32x4*)(Mm + (32 + i) * 64 + 4 * q);
#pragma unroll
            for (int e = 0; e < 4; ++e) { const f32x2v t = *(const f32x2v*)(Tf + (4 * q + e) * 64 + j0); x0 += m[e] * t[0]; x1 += m[e] * t[1]; }
        }
        Xs[i * 33 + j0] = x0; Xs[i * 33 + j0 + 1] = x1;
    }
    __syncthreads();
#ifdef PROBE3
    { const unsigned long long tq = __builtin_amdgcn_s_memrealtime(); if (PROBE3 == 5) p3acc += tq - p3t; p3t = tq; }
#endif
    {
        const int i = tid >> 4, j0 = (tid & 15) * 2;
        float x0 = 0.f, x1 = 0.f;
#pragma unroll
        for (int q = 0; q < 8; ++q) {
            const f32x4 m = *(const f32x4*)(Tf + (32 + i) * 64 + 32 + 4 * q);
#pragma unroll
            for (int e = 0; e < 4; ++e) { x0 += m[e] * Xs[(4 * q + e) * 33 + j0]; x1 += m[e] * Xs[(4 * q + e) * 33 + j0 + 1]; }
        }
        Tf[(32 + i) * 64 + j0] = -x0; Tf[(32 + i) * 64 + j0 + 1] = -x1;
    }
    __syncthreads();
#ifdef PROBE3
    { const unsigned long long tq = __builtin_amdgcn_s_memrealtime(); if (PROBE3 == 6) p3acc += tq - p3t; p3t = tq; }
#endif
    {
        const int row = tid >> 3, c0 = (tid & 7) * 8;
        const f32x4 t0 = *(const f32x4*)(Tf + row * 64 + c0), t1 = *(const f32x4*)(Tf + row * 64 + c0 + 4);
        u32x4 o = {pack2(t0[0], t0[1]), pack2(t0[2], t0[3]), pack2(t1[0], t1[1]), pack2(t1[2], t1[3])};
        *(u32x4*)(Tm + row * 72 + c0) = o;
    }
    __syncthreads();
#ifdef PROBE3
    { const unsigned long long tq = __builtin_amdgcn_s_memrealtime(); if (PROBE3 == 7) p3acc += tq - p3t; p3t = tq; }
#endif
    {
        const int dt = wv >> 1, it = wv & 1;
        f32x16 au, aw;
#pragma unroll
        for (int j = 0; j < 16; ++j) { au[j] = 0.f; aw[j] = 0.f; }
#pragma unroll
        for (int s = 0; s < 4; ++s) {
            const bf16x8 bT = *(const bf16x8*)(Tm + (32 * it + r) * 72 + 16 * s + 8 * hh);
            au = MFMA32(*(const bf16x8*)(vbT + (32 * dt + r) * 72 + 16 * s + 8 * hh), bT, au);
            aw = MFMA32(*(const bf16x8*)(kbT + (32 * dt + r) * 72 + 16 * s + 8 * hh), bT, aw);
        }
#pragma unroll
        for (int j = 0; j < 16; ++j) UT[(size_t)item * 8192 + (32 * dt + crow(j, hh)) * 64 + 32 * it + r] = f2bf(au[j]);
#pragma unroll
        for (int g = 0; g < 4; ++g) {
            u32x2 o = {pack2(-aw[4 * g], -aw[4 * g + 1]), pack2(-aw[4 * g + 2], -aw[4 * g + 3])};
            *(u32x2*)(Wg + (size_t)(row0 + 32 * it + r) * 512 + h * 128 + 32 * dt + 8 * g + 4 * hh) = o;
        }
    }
#pragma unroll
    for (int it = 0; it < 2; ++it) {
        const int c = it * 512 + tid, dk = c >> 3, t8 = (c & 7) * 8;
        *(u32x4*)(KDT + (size_t)item * 8192 + dk * 64 + t8) = *(const u32x4*)(kdTs + dk * 72 + t8);
    }
    __syncthreads();
#ifdef PROBE3
    { const unsigned long long tq = __builtin_amdgcn_s_memrealtime(); if (PROBE3 == 8) p3acc += tq - p3t; p3t = tq; }
#endif
#ifdef PROBE3
    if (threadIdx.x == 0 && blockIdx.x == 0) ((unsigned*)(p.ws + WS_CTL))[96] += (unsigned)p3acc;
#endif
}

struct HgIn { u32x4 i8a, i8b, q8a, q8b, f8a, f8b; };
DI void hg_prep_load(const P& p, int item, int tid, HgIn& in) {
    const int lane = tid & 63, wv = tid >> 6;
    const int n = item % NCH, hb = item / NCH, h = hb & 7, b = hb >> 3;
    const bf16_t* rp = (const bf16_t*)(p.ws + WS_R1) + (size_t)(b * TT + n * 64 + lane) * LD1 + h * 128 + 16 * wv;
    in.i8a = *(const u32x4*)(rp + 2048); in.i8b = *(const u32x4*)(rp + 2056);
    in.q8a = *(const u32x4*)rp; in.q8b = *(const u32x4*)(rp + 8);
    in.f8a = *(const u32x4*)(rp + 1024); in.f8b = *(const u32x4*)(rp + 1032);
}
DI void hg_prep_item(const P& p, int item, int next_item, unsigned char* lds, int tid, HgIn& in) {
    const int lane = tid & 63, wv = tid >> 6, r = lane & 31, hh = lane >> 5;
    const int n = item % NCH, hb = item / NCH, h = hb & 7, b = hb >> 3;
    const int row0 = b * TT + n * 64;
    bf16_t* proj = (bf16_t*)(p.ws + WS_R1);
    bf16_t* qs = (bf16_t*)lds;
    bf16_t* ks = qs + 64 * 136;
    bf16_t* HA = (bf16_t*)((unsigned char*)p.out + DO_HA); float* DVEC = (float*)((unsigned char*)p.out + DO_DVEC);
    const float* lbr = p.in[9];
    const int c0 = 16 * wv;
    bf16_t* rp = proj + (size_t)(row0 + lane) * LD1 + h * 128 + c0;
    const u32x4 i8a = in.i8a, i8b = in.i8b, q8a = in.q8a, q8b = in.q8b, f8a = in.f8a, f8b = in.f8b;
    float lf[16], kk[16], qq[16];
#pragma unroll
    for (int e = 0; e < 16; ++e) {
        const unsigned fw = (e < 8) ? f8a[(e & 7) >> 1] : f8b[(e & 7) >> 1], qw = (e < 8) ? q8a[(e & 7) >> 1] : q8b[(e & 7) >> 1];
        const float fv = (e & 1) ? hi16(fw) : lo16(fw), qv = (e & 1) ? hi16(qw) : lo16(qw);
        const float lb = ((const float*)(lds + 36864))[h * 128 + c0 + e];
        const float sg = sigmoidf_(fv);
        kk[e] = (1.f - lb) * (1.f - sg);
        lf[e] = 1.f - kk[e];
        qq[e] = siluf_(qv);
    }
    asm volatile("" :: "v"(i8a[3]), "v"(i8b[3]), "v"(q8b[3]), "v"(f8b[3]));
    if (next_item >= 0) hg_prep_load(p, next_item, tid, in);
    asm volatile("s_waitcnt lgkmcnt(0)\n\ts_barrier" ::: "memory");
#pragma unroll
    for (int e = 0; e < 16; ++e) {
        float x = lf[e];
        const int one = __builtin_bit_cast(int, 1.0f);
        x *= __builtin_bit_cast(float, __builtin_amdgcn_update_dpp(one, __builtin_bit_cast(int, x), 0x111, 0xf, 0xf, false));
        x *= __builtin_bit_cast(float, __builtin_amdgcn_update_dpp(one, __builtin_bit_cast(int, x), 0x112, 0xf, 0xf, false));
        x *= __builtin_bit_cast(float, __builtin_amdgcn_update_dpp(one, __builtin_bit_cast(int, x), 0x114, 0xf, 0xf, false));
        x *= __builtin_bit_cast(float, __builtin_amdgcn_update_dpp(one, __builtin_bit_cast(int, x), 0x118, 0xf, 0xf, false));
        const float r0 = __builtin_bit_cast(float, __builtin_amdgcn_readlane(__builtin_bit_cast(int, x), 15));
        const float r1 = __builtin_bit_cast(float, __builtin_amdgcn_readlane(__builtin_bit_cast(int, x), 31));
        const float r2 = __builtin_bit_cast(float, __builtin_amdgcn_readlane(__builtin_bit_cast(int, x), 47));
        x *= (lane >= 48) ? (r0 * r1 * r2) : (lane >= 32) ? (r0 * r1) : (lane >= 16) ? r0 : 1.f;
        lf[e] = x;
    }
    float qv[16], kh[16];
#pragma unroll
    for (int e = 0; e < 16; ++e) {
        const float ef = lf[e];
        const float ebl = __builtin_bit_cast(float, __builtin_amdgcn_readlane(__builtin_bit_cast(int, ef), 63));
        qv[e] = qq[e] * ef; kh[e] = kk[e] * __builtin_amdgcn_rcpf(ef);
        const int dk = c0 + e;
        bf16_t* dp = proj + (size_t)(row0 + (dk >> 1)) * LD1 + h * 128 + (dk & 1) * 64 + lane;
        dp[1024] = f2bf(kh[e] * ebl);
        const unsigned iw = (e < 8) ? i8a[(e & 7) >> 1] : i8b[(e & 7) >> 1];
        dp[2048] = (unsigned short)((e & 1) ? (iw >> 16) : (iw & 0xffffu));
        if (lane == 63) DVEC[(size_t)item * 128 + dk] = ebl;
    }
    {
        u32x4 qa = {pack2(qv[0], qv[1]), pack2(qv[2], qv[3]), pack2(qv[4], qv[5]), pack2(qv[6], qv[7])};
        u32x4 qb = {pack2(qv[8], qv[9]), pack2(qv[10], qv[11]), pack2(qv[12], qv[13]), pack2(qv[14], qv[15])};
        u32x4 ka = {pack2(kh[0], kh[1]), pack2(kh[2], kh[3]), pack2(kh[4], kh[5]), pack2(kh[6], kh[7])};
        u32x4 kb = {pack2(kh[8], kh[9]), pack2(kh[10], kh[11]), pack2(kh[12], kh[13]), pack2(kh[14], kh[15])};
        *(u32x4*)(qs + lane * 136 + c0) = qa; *(u32x4*)(qs + lane * 136 + c0 + 8) = qb;
        *(u32x4*)(ks + lane * 136 + c0) = ka; *(u32x4*)(ks + lane * 136 + c0 + 8) = kb;
        *(u32x4*)rp = qa; *(u32x4*)(rp + 8) = qb;
    }
    asm volatile("s_waitcnt lgkmcnt(0)\n\ts_barrier" ::: "memory");
    if (wv < 4) {
        const int mi = wv >> 1, ni = wv & 1;
        const bf16_t* Ap = qs + (32 * mi + r) * 136 + 8 * hh;
        const bf16_t* Bp = ks + (32 * ni + r) * 136 + 8 * hh;
        f32x16 acc;
#pragma unroll
        for (int j = 0; j < 16; ++j) acc[j] = 0.f;
#pragma unroll
        for (int s = 0; s < 8; ++s) acc = MFMA32(*(const bf16x8*)(Ap + 16 * s), *(const bf16x8*)(Bp + 16 * s), acc);
        const int jt = 32 * ni + r;
#pragma unroll
        for (int j = 0; j < 16; ++j) { const int i = 32 * mi + crow(j, hh); HA[(size_t)item * 4096 + i * 64 + jt] = f2bf((jt <= i) ? acc[j] : 0.f); }
    }
}

struct ScanPtrs { const bf16_t *qd, *wq, *Am, *kdT, *uT, *zg; const float *dvec, *gn; bf16_t* outp; int qld, zld; size_t cs; int s2; };
constexpr int SC_W = 0, SC_Q = 16896, SC_A = 33792, SC_K = 42496, SC_U = 59904, SC_O = 77312, SC_D = 144896, SC_G = 145408;
template <int KIND>
DI void scan_issue(const ScanPtrs& sp, int n, int lt, u32x4 (&rw)[4], u32x4 (&rq)[4], u32x4 (&ra)[2], u32x4 (&rk)[4], u32x4 (&ru)[4], f32x4& rd) {
    const int t0 = n * 64;
#pragma unroll
    for (int i = 0; i < 4; ++i) {
        const int c = i * 256 + lt, row = c >> 4, col = (c & 15) * 8;
        if (KIND == 0) rw[i] = *(const u32x4*)(sp.wq + (size_t)(t0 + row) * sp.qld + col);
        rq[i] = *(const u32x4*)(sp.qd + (size_t)(t0 + row) * sp.qld + col);
    }
#pragma unroll
    for (int i = 0; i < 2; ++i) { const int c = i * 256 + lt, row = c >> 3, col = (c & 7) * 8; ra[i] = *(const u32x4*)(sp.Am + (size_t)n * 4096 + row * 64 + col); }
#pragma unroll
    for (int i = 0; i < 4; ++i) {
        const int c = i * 256 + lt, dk = c >> 3, t8 = (c & 7) * 8;
        const size_t off = (size_t)n * sp.cs + (size_t)(dk >> 1) * sp.s2 + (dk & 1) * 64 + t8;
        rk[i] = *(const u32x4*)(sp.kdT + off); ru[i] = *(const u32x4*)(sp.uT + off);
    }
    if (lt < 32) { if (KIND == 0) { const float d = sp.dvec[n]; rd = (f32x4){d, d, d, d}; } else rd = *(const f32x4*)(sp.dvec + (size_t)n * 128 + lt * 4); }
}
DI void st16(bf16_t* p, const u32x4& v) { *(u32x2*)p = (u32x2){v[0], v[1]}; *(u32x2*)(p + 4) = (u32x2){v[2], v[3]}; }
template <int KIND>
DI void scan_fill(unsigned char* lds, int lt, const u32x4 (&rw)[4], const u32x4 (&rq)[4], const u32x4 (&ra)[2], const u32x4 (&rk)[4], const u32x4 (&ru)[4], const f32x4& rd) {
#pragma unroll
    for (int i = 0; i < 4; ++i) {
        const int c = i * 256 + lt, row = c >> 4, col = (c & 15) * 8;
        if (KIND == 0) st16((bf16_t*)(lds + SC_W) + row * 132 + col, rw[i]);
        st16((bf16_t*)(lds + SC_Q) + row * 132 + col, rq[i]);
    }
#pragma unroll
    for (int i = 0; i < 2; ++i) { const int c = i * 256 + lt, row = c >> 3, col = (c & 7) * 8; st16((bf16_t*)(lds + SC_A) + row * 68 + col, ra[i]); }
#pragma unroll
    for (int i = 0; i < 4; ++i) {
        const int c = i * 256 + lt, dk = c >> 3, t8 = (c & 7) * 8;
        st16((bf16_t*)(lds + SC_K) + dk * 68 + t8, rk[i]); st16((bf16_t*)(lds + SC_U) + dk * 68 + t8, ru[i]);
    }
    if (lt < 32) *(f32x4*)((float*)(lds + SC_D) + lt * 4) = rd;
}
DI void scan_zload(const ScanPtrs& sp, int m, int lt, u32x4 (&zr)[4]) {
    const int row = lt >> 2, c0 = (lt & 3) * 32;
    const bf16_t* zp = sp.zg + (size_t)(m * 64 + row) * sp.zld + c0;
#pragma unroll
    for (int i = 0; i < 4; ++i) zr[i] = *(const u32x4*)(zp + 8 * i);
}
DI void scan_epilogue(const ScanPtrs& sp, unsigned char* lds, int m, int lt, const u32x4 (&zr)[4]) {
    const int row = lt >> 2, c0 = (lt & 3) * 32;
    const float* ob = (const float*)(lds + SC_O) + (m & 1) * 64 * 132 + row * 132 + c0;
    const float* gl = (const float*)(lds + SC_G) + c0;
    float ss = 0.f;
#pragma unroll
    for (int i = 0; i < 8; ++i) { const f32x4 v = *(const f32x4*)(ob + 4 * i); ss += v[0] * v[0] + v[1] * v[1] + v[2] * v[2] + v[3] * v[3]; }
    ss += __shfl_xor(ss, 1); ss += __shfl_xor(ss, 2);
    const float inv = rsqrtf(ss * (1.f / 128.f) + 1e-6f);
    bf16_t* op = sp.outp + (size_t)(m * 64 + row) * DM + c0;
#pragma unroll
    for (int i = 0; i < 8; ++i) {
        const f32x4 g0 = *(const f32x4*)(gl + 4 * i);
        const f32x4 a = *(const f32x4*)(ob + 4 * i);
        const unsigned z0 = zr[i >> 1][(i & 1) * 2], z1 = zr[i >> 1][(i & 1) * 2 + 1];
        u32x2 o;
        o[0] = pack2(a[0] * inv * g0[0] * lo16(z0), a[1] * inv * g0[1] * hi16(z0));
        o[1] = pack2(a[2] * inv * g0[2] * lo16(z1), a[3] * inv * g0[3] * hi16(z1));
        *(u32x2*)(op + 4 * i) = o;
    }
}
template <int KIND>
DI void scan_chain(const P& p, int chain, unsigned char* lds) {
#if defined(PROBE2) && PROBE2 == 4
    const unsigned long long e0 = __builtin_amdgcn_s_memrealtime();
#endif
    const int tid = my_tid(), lane = tid & 63, wv = __builtin_amdgcn_readfirstlane(tid >> 6), r = lane & 31, hh = lane >> 5, lt = tid - 256;
    const int h = KIND == 0 ? (chain & 3) : (chain & 7), b = KIND == 0 ? (chain >> 2) : (chain >> 3);
    const size_t rb = (size_t)b * TT;
    const bf16_t* r1 = (const bf16_t*)(p.ws + WS_R1);
    ScanPtrs sp;
    if (KIND == 0) {
        sp.qd = (const bf16_t*)((unsigned char*)p.out + DO_QD) + rb * 512 + h * 128; sp.wq = (const bf16_t*)((unsigned char*)p.out + DO_W) + rb * 512 + h * 128; sp.qld = 512;
        sp.Am = (const bf16_t*)(p.ws + WS_GA) + (size_t)chain * NCH * 4096;
        sp.kdT = (const bf16_t*)(p.ws + WS_KDT) + (size_t)chain * NCH * 8192; sp.uT = (const bf16_t*)((unsigned char*)p.out + DO_UT) + (size_t)chain * NCH * 8192; sp.cs = 8192; sp.s2 = 128;
        sp.dvec = (const float*)(p.ws + WS_GT) + (size_t)chain * NCH; sp.zg = r1 + rb * N0 + 1536 + h * 128; sp.zld = N0; sp.gn = p.in[6];
    } else {
        sp.qd = r1 + rb * LD1 + h * 128; sp.wq = sp.qd; sp.qld = LD1;
        sp.Am = (const bf16_t*)((unsigned char*)p.out + DO_HA) + (size_t)chain * NCH * 4096;
        sp.kdT = r1 + rb * LD1 + 1024 + h * 128; sp.uT = r1 + rb * LD1 + 2048 + h * 128; sp.cs = (size_t)64 * LD1; sp.s2 = LD1;
        sp.dvec = (const float*)((unsigned char*)p.out + DO_DVEC) + (size_t)chain * NCH * 128; sp.zg = r1 + rb * LD1 + 3072 + h * 128; sp.zld = LD1; sp.gn = p.in[10];
    }
    sp.outp = (bf16_t*)(p.ws + WS_MIX) + rb * DM + h * 128;
    const bf16_t* Wl = (const bf16_t*)(lds + SC_W); const bf16_t* Ql = (const bf16_t*)(lds + SC_Q); const bf16_t* Al = (const bf16_t*)(lds + SC_A);
    const bf16_t* Kl = (const bf16_t*)(lds + SC_K); const bf16_t* Ul = (const bf16_t*)(lds + SC_U); const float* Dl = (const float*)(lds + SC_D);
    float* obuf = (float*)(lds + SC_O);
    u32x4 rwA[4], rqA[4], raA[2], rkA[4], ruA[4]; f32x4 rdA = {0.f, 0.f, 0.f, 0.f};
    if (wv >= 4) {
        if (lt < 32) *(f32x4*)((float*)(lds + SC_G) + lt * 4) = *(const f32x4*)(sp.gn + lt * 4);
        scan_issue<KIND>(sp, 1, lt, rwA, rqA, raA, rkA, ruA, rdA); scan_fill<KIND>(lds, lt, rwA, rqA, raA, rkA, ruA, rdA);
        scan_issue<KIND>(sp, 2, lt, rwA, rqA, raA, rkA, ruA, rdA);
    }
    __syncthreads();
    const int dv0 = 32 * wv;
#define SCHED __builtin_amdgcn_sched_barrier(0)
#define LBAR() asm volatile("s_waitcnt lgkmcnt(0)\n\ts_barrier" ::: "memory")
#define LW(f, base, half) do { _Pragma("unroll") for (int _i = 0; _i < 4; ++_i) f[_i] = loadA((base) + 32 * (((half) * 4 + _i) >> 1) + 16 * (_i & 1)); } while (0)
#define MS(acc, f, half) do { _Pragma("unroll") for (int _i = 0; _i < 4; ++_i) acc = MFMA32(f[_i], Sb[((half) * 4 + _i) >> 1][_i & 1], acc); } while (0)
#define LK(f, kt) do { _Pragma("unroll") for (int _i = 0; _i < 4; ++_i) f[_i] = loadA(Kl + (32 * (kt) + r) * 68 + 32 * (_i >> 1) + 16 * (_i & 1) + 4 * hh); \
                       _Pragma("unroll") for (int _g = 0; _g < 4; ++_g) dcy[_g] = *(const f32x4*)(Dl + 32 * (kt) + 8 * _g + 4 * hh); } while (0)
#define SU(kt, f) do { _Pragma("unroll") for (int _g = 0; _g < 4; ++_g) _Pragma("unroll") for (int _e = 0; _e < 4; ++_e) S[kt][4 * _g + _e] *= dcy[_g][_e]; \
                       _Pragma("unroll") for (int _i = 0; _i < 4; ++_i) S[kt] = MFMA32(f[_i], vb[_i >> 1][_i & 1], S[kt]); } while (0)
#if defined(PROBE2) && PROBE2 == 4
    if (KIND == 0 && threadIdx.x == 0 && blockIdx.x == 0) ((unsigned*)(p.ws + WS_CTL))[96] = (unsigned)(__builtin_amdgcn_s_memrealtime() - e0);
#endif
    if (wv < 4) {
        f32x16 S[4];
#pragma unroll
        for (int kt = 0; kt < 4; ++kt)
#pragma unroll
            for (int j = 0; j < 16; ++j) S[kt][j] = 0.f;
#ifdef PROBE_SEL
        unsigned long long tacc = 0ull;
#endif
#pragma unroll 1
        for (int n = 1; n < NCH; ++n) {
#ifdef PROBE_SEL
            const unsigned long long pt0 = __builtin_amdgcn_s_memrealtime();
#endif
            u32x4 zr[4];
            scan_zload(sp, n, tid, zr);
            bf16x8 f0[4], f1[4];
            f32x16 vn[2], o[2];
            f32x4 dcy[4];
            const bf16_t* w0 = Wl + r * 132 + 4 * hh; const bf16_t* w1 = Wl + (32 + r) * 132 + 4 * hh;
            const bf16_t* q0 = Ql + r * 132 + 4 * hh; const bf16_t* q1 = Ql + (32 + r) * 132 + 4 * hh;
            if (KIND == 0) { LW(f0, w0, 0); LW(f1, w0, 1); } else { LW(f0, q0, 0); LW(f1, q0, 1); }
            const bf16_t* up = Ul + (dv0 + r) * 68 + 4 * hh;
            if (KIND == 0) {
#pragma unroll
                for (int mt = 0; mt < 2; ++mt)
#pragma unroll
                    for (int g = 0; g < 4; ++g) {
                        const u32x2 raw = *(const u32x2*)(up + 32 * mt + 8 * g);
                        vn[mt][4 * g] = lo16(raw[0]); vn[mt][4 * g + 1] = hi16(raw[0]); vn[mt][4 * g + 2] = lo16(raw[1]); vn[mt][4 * g + 3] = hi16(raw[1]);
                    }
            }
            bf16x8 Sb[4][2];
#pragma unroll
            for (int kt = 0; kt < 4; ++kt) { Sb[kt][0] = pack8(S[kt], 0); Sb[kt][1] = pack8(S[kt], 1); }
            SCHED;
            if (KIND == 0) {
                MS(vn[0], f0, 0); SCHED; LW(f0, w1, 0); SCHED; MS(vn[0], f1, 1);
                SCHED; LW(f1, w1, 1); SCHED;
                MS(vn[1], f0, 0); SCHED; LW(f0, q0, 0); SCHED; MS(vn[1], f1, 1);
                SCHED; LW(f1, q0, 1); SCHED;
            }
#pragma unroll
            for (int j = 0; j < 16; ++j) { o[0][j] = 0.f; o[1][j] = 0.f; }
            MS(o[0], f0, 0); SCHED; LW(f0, q1, 0); SCHED; MS(o[0], f1, 1); SCHED; LW(f1, q1, 1); SCHED;
            MS(o[1], f0, 0); SCHED;
            f0[0] = loadA(Al + r * 68 + 4 * hh); f0[1] = loadA(Al + r * 68 + 16 + 4 * hh); f0[2] = loadA(Al + (32 + r) * 68 + 4 * hh);
            SCHED; MS(o[1], f1, 1);
            bf16x8 vb[2][2];
            if (KIND == 0) {
#pragma unroll
                for (int mt = 0; mt < 2; ++mt) { vb[mt][0] = pack8(vn[mt], 0); vb[mt][1] = pack8(vn[mt], 1); }
            } else {
#pragma unroll
                for (int mt = 0; mt < 2; ++mt) { vb[mt][0] = loadA(up + 32 * mt); vb[mt][1] = loadA(up + 32 * mt + 16); }
            }
            SCHED;
            f1[0] = loadA(Al + (32 + r) * 68 + 16 + 4 * hh); f1[1] = loadA(Al + (32 + r) * 68 + 32 + 4 * hh); f1[2] = loadA(Al + (32 + r) * 68 + 48 + 4 * hh);
            SCHED;
            o[0] = MFMA32(f0[0], vb[0][0], o[0]); o[1] = MFMA32(f0[2], vb[0][0], o[1]); o[0] = MFMA32(f0[1], vb[0][1], o[0]);
            SCHED; LK(f0, 0); SCHED;
            o[1] = MFMA32(f1[0], vb[0][1], o[1]); o[1] = MFMA32(f1[1], vb[1][0], o[1]); o[1] = MFMA32(f1[2], vb[1][1], o[1]);
            SCHED;
            SU(0, f0); SCHED; LK(f1, 1); SCHED; SU(1, f1); SCHED; LK(f0, 2); SCHED; SU(2, f0); SCHED; LK(f1, 3); SCHED; SU(3, f1);
            float* ob = obuf + (n & 1) * 64 * 132 + dv0 + r;
#pragma unroll
            for (int mt = 0; mt < 2; ++mt)
#pragma unroll
                for (int j = 0; j < 16; ++j) ob[(32 * mt + crow(j, hh)) * 132] = o[mt][j];
#ifdef PROBE_SEL
            asm volatile("s_waitcnt lgkmcnt(0)" ::: "memory");
            const unsigned long long pt1 = __builtin_amdgcn_s_memrealtime();
            LBAR();
            const unsigned long long pt2 = __builtin_amdgcn_s_memrealtime();
            scan_epilogue(sp, lds, n, tid, zr);
            LBAR();
            const unsigned long long pt3 = __builtin_amdgcn_s_memrealtime();
            tacc += (PROBE_SEL == 1) ? (pt1 - pt0) : (PROBE_SEL == 2) ? (pt2 - pt1) : (pt3 - pt2);
#else
            LBAR();
            scan_epilogue(sp, lds, n, tid, zr);
            LBAR();
#endif
        }
#ifdef PROBE_SEL
        if (KIND == PROBE_KIND && blockIdx.x == 0 && wv == 0) {
            const unsigned long long ps = __builtin_amdgcn_s_memrealtime();
            while (__builtin_amdgcn_s_memrealtime() - ps < tacc * PROBE_MUL) __builtin_amdgcn_s_sleep(8);
        }
#endif
    } else {
        u32x4 rwB[4], rqB[4], raB[2], rkB[4], ruB[4]; f32x4 rdB = {0.f, 0.f, 0.f, 0.f};
#define LBODY(n_, XW, XQ, XA, XK, XU, XD, YW, YQ, YA, YK, YU, YD, ZC, ZN) do { \
            if ((n_) + 2 < NCH) scan_issue<KIND>(sp, (n_) + 2, lt, YW, YQ, YA, YK, YU, YD); \
            LBAR(); \
            if ((n_) + 1 < NCH) scan_fill<KIND>(lds, lt, XW, XQ, XA, XK, XU, XD); \
            LBAR(); } while (0)
#pragma unroll 1
        for (int n = 1; n < NCH; n += 2) {
            LBODY(n, rwA, rqA, raA, rkA, ruA, rdA, rwB, rqB, raB, rkB, ruB, rdB, zrB, zrA);
            if (n + 1 < NCH) LBODY(n + 1, rwB, rqB, raB, rkB, ruB, rdB, rwA, rqA, raA, rkA, ruA, rdA, zrA, zrB);
        }
#undef LBODY
    }
#undef SCHED
#undef LBAR
#undef LW
#undef MS
#undef LK
#undef SU
    __syncthreads();
}

DI void sb_item(const P& p, int item, bf16_t* vT  , int lane) {
    const int r = lane & 31, hh = lane >> 5;
    const int bh = item / 129, qt = 131 - (item - bh * 129), b = bh >> 3, h = bh & 7;
    const bf16_t* base = (const bf16_t*)(p.ws + WS_R1) + (size_t)b * TT * N0;
    const int q0 = 32 * qt, qpos = q0 + r;
    bf16x8 qf[4];
#pragma unroll
    for (int s = 0; s < 4; ++s) qf[s] = *(const bf16x8*)(base + (size_t)(q0 + r) * N0 + 2048 + h * 64 + 16 * s + 8 * hh);
    f32x16 o[2];
#pragma unroll
    for (int j = 0; j < 16; ++j) { o[0][j] = 0.f; o[1][j] = 0.f; }
    float R = 0.f;
#pragma unroll 1
    for (int kt = qt; kt >= 3; --kt) {
        const int k0 = 32 * kt;
        f32x16 z;
#pragma unroll
        for (int j = 0; j < 16; ++j) z[j] = 0.f;
#pragma unroll
        for (int s = 0; s < 4; ++s) z = MFMA32(*(const bf16x8*)(base + (size_t)(k0 + r) * N0 + 2560 + h * 64 + 16 * s + 8 * hh), qf[s], z);
#pragma unroll
        for (int i = 0; i < 4; ++i) {
            const int c = i * 64 + lane, key = c >> 3, d0 = (c & 7) * 8;
            const u32x4 v8 = *(const u32x4*)(base + (size_t)(k0 + key) * N0 + 3072 + h * 64 + d0);
#pragma unroll
            for (int e = 0; e < 8; ++e) vT[(d0 + e) * 36 + key] = (unsigned short)((e & 1) ? (v8[e >> 1] >> 16) : (v8[e >> 1] & 0xffffu));
        }
        float l[16], ls[16], suf[16]; bool al[16];
#pragma unroll
        for (int j = 0; j < 16; ++j) {
            const int key = k0 + crow(j, hh);
            const float zz = z[j] * 0.125f;
            al[j] = (key < qpos) && (key >= PADF);
            const float sp = softplusf_(zz);
            l[j] = al[j] ? -sp : 0.f; ls[j] = zz - sp;
        }
        float G[4], Pg[4], offs[4];
#pragma unroll
        for (int g = 0; g < 4; ++g) {
            suf[4 * g + 3] = 0.f; suf[4 * g + 2] = l[4 * g + 3]; suf[4 * g + 1] = suf[4 * g + 2] + l[4 * g + 2]; suf[4 * g] = suf[4 * g + 1] + l[4 * g + 1];
            G[g] = suf[4 * g] + l[4 * g];
            Pg[g] = __shfl_xor(G[g], 32);
        }
        float tail = 0.f;
#pragma unroll
        for (int g = 3; g >= 0; --g) { offs[g] = tail + (hh == 0 ? Pg[g] : 0.f); tail += G[g] + Pg[g]; }
        f32x16 pw;
#pragma unroll
        for (int j = 0; j < 16; ++j) pw[j] = al[j] ? __expf(ls[j] + R + offs[j >> 2] + suf[j]) : 0.f;
        R += tail;
        const bf16x8 pb0 = pack8(pw, 0), pb1 = pack8(pw, 1);
#pragma unroll
        for (int mt = 0; mt < 2; ++mt) {
            o[mt] = MFMA32(loadA(vT + (32 * mt + r) * 36 + 4 * hh), pb0, o[mt]);
            o[mt] = MFMA32(loadA(vT + (32 * mt + r) * 36 + 16 + 4 * hh), pb1, o[mt]);
        }
        if (__ballot(R > -105.f) == 0ull) break;
    }
    bf16_t* op = (bf16_t*)(p.ws + WS_MIX) + ((size_t)b * TT + q0 + r) * DM + 512 + h * 64 + 4 * hh;
#pragma unroll
    for (int mt = 0; mt < 2; ++mt)
#pragma unroll
        for (int g = 0; g < 4; ++g) {
            u32x2 w = {pack2(o[mt][4 * g], o[mt][4 * g + 1]), pack2(o[mt][4 * g + 2], o[mt][4 * g + 3])};
            *(u32x2*)(op + 32 * mt + 8 * g) = w;
        }
}

#define XB_TMO      128
#define XB_XCNT(j)  (256  + 64 * (j))
#define XB_XSUB(j)  (1280 + 64 * (j))
#define XB_XGEN(j)  (2304 + 64 * (j))
#define XB_TOP      3328
#define XB_TOPGEN   3392
#define XCD_BAR_WORDS 3456
#define XB_SPIN_CAP (1u << 18)
#define LAS __attribute__((address_space(3)))

__device__ __forceinline__ unsigned xb_ld(unsigned* p)              { return __hip_atomic_load(p, __ATOMIC_RELAXED, __HIP_MEMORY_SCOPE_AGENT); }
__device__ __forceinline__ unsigned xb_add(unsigned* p, unsigned v) { return __hip_atomic_fetch_add(p, v, __ATOMIC_RELAXED, __HIP_MEMORY_SCOPE_AGENT); }
__device__ __forceinline__ unsigned xb_xcc_id() { return (unsigned)__builtin_amdgcn_s_getreg((3 << 11) | 20) & 0xFu; }
#define XB_SPIN(cond, bar) do { unsigned _sp = 0; while (cond) { __builtin_amdgcn_s_sleep(1); \
    if ((++_sp & 255u) == 0u) { if (xb_ld(&(bar)[XB_TMO])) break; if (_sp > XB_SPIN_CAP) { atomicAdd(&(bar)[XB_TMO], 1u); break; } } } } while (0)

struct XcdBarrier {
    unsigned* bar; unsigned x;
    volatile LAS unsigned* st;
};

__device__ __forceinline__ XcdBarrier xcd_barrier_post(unsigned* bar, volatile LAS unsigned* st) {
    XcdBarrier b; b.bar = bar; b.x = xb_xcc_id(); b.st = st;
    if (threadIdx.x == 0) (void)xb_add(&bar[XB_XCNT(b.x)], 1u);
    return b;
}
__device__ __forceinline__ void xcd_barrier_complete(unsigned* bar, unsigned x, unsigned& nloc, unsigned& nx) {
    const unsigned G = gridDim.x * gridDim.y * gridDim.z;
    unsigned sum, cnt, mine, sp = 0u;
    for (;;) {
        sum = 0u; cnt = 0u; mine = 0u;
#pragma unroll
        for (unsigned j = 0; j < 16; ++j) { const unsigned c = xb_ld(&bar[XB_XCNT(j)]); sum += c; cnt += (c > 0u) ? 1u : 0u; mine = (j == x) ? c : mine; }
        if (sum == G) break;
        __builtin_amdgcn_s_sleep(1);
        if ((++sp & 255u) == 0u) { if (xb_ld(&bar[XB_TMO])) break; if (sp > XB_SPIN_CAP) { atomicAdd(&bar[XB_TMO], 1u); break; } }
    }
    nloc = mine > 0u ? mine : 1u; nx = cnt > 0u ? cnt : 1u;
}

__device__ __forceinline__ void xcd_barrier(const XcdBarrier& b) {
    asm volatile("s_waitcnt vmcnt(0)" ::: "memory");
    __syncthreads();
    if (threadIdx.x == 0) {
        unsigned* bar = b.bar;
        __builtin_amdgcn_s_waitcnt(0);
        unsigned nloc = b.st[0], nx = b.st[1];
        if (nloc == 0u) { xcd_barrier_complete(bar, b.x, nloc, nx); b.st[0] = nloc; b.st[1] = nx; }
        const unsigned old = xb_add(&bar[XB_XSUB(b.x)], 1u);
        const unsigned gen = old / nloc;
        if (old + 1u == (gen + 1u) * nloc) {
            __builtin_amdgcn_fence(__ATOMIC_RELEASE, "agent");
            asm volatile("s_waitcnt vmcnt(0)" ::: "memory");
            const unsigned og = xb_add(&bar[XB_TOP], 1u);
            const unsigned tg = og / nx;
            if (og + 1u == (tg + 1u) * nx) xb_add(&bar[XB_TOPGEN], 1u);
            else XB_SPIN(xb_ld(&bar[XB_TOPGEN]) == tg, bar);
            __builtin_amdgcn_fence(__ATOMIC_ACQUIRE, "agent");
            xb_add(&bar[XB_XGEN(b.x)], 1u);
            asm volatile("s_waitcnt vmcnt(0)" ::: "memory");
        } else {
            XB_SPIN(xb_ld(&bar[XB_XGEN(b.x)]) == gen, bar);
            __builtin_amdgcn_fence(__ATOMIC_ACQUIRE, "agent");
            asm volatile("s_waitcnt vmcnt(0)" ::: "memory");
        }
    }
    __syncthreads();
}


constexpr int NPHASE = 17;
#ifndef KSEL
#define KSEL 0x1ff
#endif
#define KON(k) (((KSEL) >> (k)) & 1)
#ifndef DUP_MASK
#define DUP_MASK 0
#endif
__global__ __launch_bounds__(512) void mega(P p) {
    extern __shared__ __attribute__((aligned(16))) unsigned char shm[];
    cg::grid_group grid = cg::this_grid();
    bf16_t* h16 = (bf16_t*)(p.ws + WS_H16); bf16_t* r1 = (bf16_t*)(p.ws + WS_R1); bf16_t* mix = (bf16_t*)(p.ws + WS_MIX);
    float* side = (float*)(p.ws + WS_SIDE);
    unsigned* ctl = (unsigned*)(p.ws + WS_CTL);
    volatile LAS unsigned* xst = (volatile LAS unsigned*)(shm + LDS_BYTES - 16);
    if (threadIdx.x == 0) { xst[0] = 0u; xst[1] = 0u; }
    __syncthreads();
    XcdBarrier xbar = xcd_barrier_post(ctl, xst);
    int nsync = 0;
#ifdef SYNC_EXTRA
    for (int i = 0; i < SYNC_EXTRA; ++i) xcd_barrier(xbar);
#endif
#pragma unroll 1
    for (int phx = p.ph_lo * 2; phx < p.ph_hi * 2; ++phx) {
        const int ph = phx >> 1, rep = phx & 1;
        if (rep && !((DUP_MASK >> ph) & 1)) continue;
        int kind = 0;
        pg8::Gemm g{}; bf16_t* O = nullptr; int ldc = 0, act = 0; const float* lg = nullptr; const float* lb = nullptr; int fin = 0; bf16_t* Y = nullptr; int sl = 0, sh = 0, nk = 0;
        g.M = MROWS; g.K = 1024; g.xonly = 0; g.lda = 1024; g.ldb = 1024;
        switch (ph) {
            case 0: kind = 4; break;
            case 1: kind = 1; g.A = h16; g.Bt = (const bf16_t*)(p.ws + WS_WAB); g.N = N0; O = r1; ldc = N0; sl = 6; sh = 8; break;
            case 2: kind = 5; break;
            case 3: kind = 6; break;
            case 4: kind = 2; g.A = mix; g.Bt = (const bf16_t*)(p.ws + WS_WABO); g.N = 1024; Y = r1; g.M = TAIL0; nk = 4; break;
            case 5: kind = 3; lg = p.in[12]; lb = p.in[13]; Y = r1; nk = 4; break;
            case 6: kind = 1; g.A = h16; g.Bt = (const bf16_t*)(p.ws + WS_W1); g.N = 4096; O = r1; ldc = LD1; act = 1; break;
            case 7: kind = 2; g.A = r1; g.Bt = (const bf16_t*)(p.ws + WS_W2); g.N = 1024; g.K = 4096; g.lda = LD1; g.ldb = 4096; Y = mix; g.M = TAIL0; nk = 16; break;
            case 8: kind = 3; lg = p.in[16]; lb = p.in[17]; Y = mix; nk = 16; break;
            case 9: kind = 1; g.A = h16; g.Bt = (const bf16_t*)(p.ws + WS_WC); g.N = N1; O = r1; ldc = LD1; sl = 12; sh = 16; break;
            case 10: kind = 7; break;
            case 11: kind = 8; break;
            case 12: kind = 2; g.A = mix; g.Bt = (const bf16_t*)(p.ws + WS_WCO); g.N = 1024; Y = r1; g.M = NB * SEQ; g.xonly = 1; break;
            case 13: kind = 3; lg = p.in[12] + 1024; lb = p.in[13] + 1024; Y = r1; g.xonly = 1; break;
            case 14: kind = 1; g.A = h16; g.Bt = (const bf16_t*)(p.ws + WS_W1) + (size_t)4096 * 1024; g.N = 4096; O = r1; ldc = LD1; act = 1; g.M = NB * SEQ; g.xonly = 1; break;
            case 15: kind = 2; g.A = r1; g.Bt = (const bf16_t*)(p.ws + WS_W2) + (size_t)4096 * 1024; g.N = 1024; g.K = 4096; g.lda = LD1; g.ldb = 4096; Y = mix; g.M = NB * SEQ; g.xonly = 1; break;
            default: kind = 3; lg = p.in[16] + 1024; lb = p.in[17] + 1024; fin = 1; Y = mix; g.xonly = 1; break;
        }
        if (KON(1) && kind == 1) {
            pg8::StaticOrder S; S.init(g.M, g.N, (int)gridDim.x, (int)blockIdx.x);
            EpiStore E{O, ldc, act, g.xonly, sl, sh};
            pg8::gemm_phase<EpiStore, pg8::StaticOrder, false>((PG8_LAS unsigned char*)shm, g, S, E, nullptr);
        } else if (KON(2) && kind == 2) {
            pg8::StaticOrder S; S.init(g.M, g.N, (int)gridDim.x, (int)blockIdx.x);
            EpiResid E{h16, Y, g.xonly};
            pg8::gemm_phase<EpiResid, pg8::StaticOrder, false>((PG8_LAS unsigned char*)shm, g, S, E, nullptr);
            if (nk > 0) {
                pg8::Gemm gt = g; gt.K = 256;
                pg8::TailOrder T; T.npieces = 16 * nk; T.nk = nk; T.pm0 = TAIL0 / 256; T.G = (int)gridDim.x; T.c = (int)blockIdx.x;
                EpiPart EP{p.out, TAIL0};
                pg8::gemm_phase<EpiPart, pg8::TailOrder, false>((PG8_LAS unsigned char*)shm, gt, T, EP, nullptr);
            }
        } else if (KON(3) && kind == 3) {
            ln_phase(p, Y, lg, lb, g.xonly, fin, nk);
        } else if (KON(4) && kind == 4) {
            prep_phase(p, shm, 0, (int)blockIdx.x, (int)gridDim.x);
        } else if (KON(5) && kind == 5) {
            for (int it = blockIdx.x; it < NB * 4 * NCH; it += gridDim.x) gdn_prep_item(p, it, shm);
        } else if (KON(6) && kind == 6) {
#ifdef PROBE2
            const unsigned long long q0 = __builtin_amdgcn_s_memrealtime();
#endif
            for (int ch = blockIdx.x; ch < NB * 4; ch += gridDim.x) scan_chain<0>(p, ch, shm);
#ifdef PROBE2
            const unsigned long long q1 = __builtin_amdgcn_s_memrealtime();
#endif
            const int tid = my_tid();
            bf16_t* vT = (bf16_t*)shm + (tid >> 6) * (64 * 36);
            for (;;) {
                int it = 0;
                if ((tid & 63) == 0) it = (int)atomicAdd(ctl + rep, 1u);
                it = __builtin_amdgcn_readfirstlane(it);
                if (it >= SB_ITEMS) break;
                sb_item(p, it, vT, tid & 63);
            }
            __syncthreads();
            { int bid = blockIdx.x, gsz = gridDim.x; asm volatile("" : "+s"(bid), "+s"(gsz));
              if (rep == 0) { if (gsz > NB * 4) { if (bid >= NB * 4) prep_phase(p, shm, 1, bid - NB * 4, gsz - NB * 4); } else prep_phase(p, shm, 1, bid, gsz); } }
#ifdef PROBE2
            { const unsigned long long q2 = __builtin_amdgcn_s_memrealtime();
              if (rep == 0 && threadIdx.x == 0 && (int)blockIdx.x == ((PROBE2 == 1) ? 0 : 255) && PROBE2 < 3) ctl[96] = (unsigned)((PROBE2 == 1) ? (q1 - q0) : (q2 - q0)); }
#endif
        } else if (KON(7) && kind == 7) {
            { const int tid = my_tid(); HgIn hin;
              { const float* lbr = p.in[9]; float* lbs = (float*)(shm + 36864);
                for (int i = tid; i < 1024; i += 512) lbs[i] = sigmoidf_(lbr[1024 + i] - lbr[i]);
                __syncthreads(); }
              hin.i8a = hin.i8b = hin.q8a = hin.q8b = hin.f8a = hin.f8b = (u32x4){0u, 0u, 0u, 0u};
              int it = blockIdx.x;
              if (it < NB * 8 * NCH) hg_prep_load(p, it, tid, hin);
              for (; it < NB * 8 * NCH; it += gridDim.x) { const int nx = it + (int)gridDim.x; hg_prep_item(p, it, nx < NB * 8 * NCH ? nx : -1, shm, tid, hin); } }
        } else if (KON(8) && kind == 8) {
#if defined(PROBE2) && PROBE2 == 3
            const unsigned long long q0 = __builtin_amdgcn_s_memrealtime();
#endif
            for (int ch = blockIdx.x; ch < NB * 8; ch += gridDim.x) scan_chain<1>(p, ch, shm);
#if defined(PROBE2) && PROBE2 == 3
            if (rep == 0 && threadIdx.x == 0 && blockIdx.x == 0) ctl[96] = (unsigned)(__builtin_amdgcn_s_memrealtime() - q0);
#endif
            { int bid = blockIdx.x, gsz = gridDim.x; asm volatile("" : "+s"(bid), "+s"(gsz));
              if (rep == 0) { if (gsz > NB * 8) { if (bid >= NB * 8) prep_phase(p, shm, 2, bid - NB * 8, gsz - NB * 8); } else prep_phase(p, shm, 2, bid, gsz); } }
        }
        if (!(ph == p.ph_hi - 1 && rep == ((DUP_MASK >> ph) & 1))) { if (nsync == 0) grid.sync(); else xcd_barrier(xbar); ++nsync; }
    }
#ifdef PROBE3
    if (threadIdx.x == 0 && blockIdx.x == 0) {
        const unsigned long long t = (unsigned long long)ctl[96] * 2ull, ps = __builtin_amdgcn_s_memrealtime();
        while (__builtin_amdgcn_s_memrealtime() - ps < t) __builtin_amdgcn_s_sleep(8);
    }
#endif
#ifdef PROBE2
    if (threadIdx.x == 0 && (int)blockIdx.x == ((PROBE2 == 2) ? 255 : 0)) {
        const unsigned long long t = (unsigned long long)ctl[96] * 2ull, ps = __builtin_amdgcn_s_memrealtime();
        while (__builtin_amdgcn_s_memrealtime() - ps < t) __builtin_amdgcn_s_sleep(8);
    }
#endif
}

extern "C" void kernel_launch(void* const* d_in, const int* in_sizes, int n_in, void* d_out, int out_size, void* d_ws, size_t ws_size, hipStream_t stream) {
    static int grid = 0;
    if (grid == 0) {
        if (n_in != 18 || out_size != NB * SEQ * DM || ws_size < WS_END) { fprintf(stderr, "kernel_launch: unexpected shapes (n_in %d out %d ws %zu need %zu)\n", n_in, out_size, ws_size, (size_t)WS_END); grid = -1; return; }
        int dev = 0, cus = 0, per_cu = 0;
        hipGetDevice(&dev);
        hipDeviceGetAttribute(&cus, hipDeviceAttributeMultiprocessorCount, dev);
        if (hipFuncSetAttribute((const void*)mega, hipFuncAttributeMaxDynamicSharedMemorySize, LDS_BYTES) != hipSuccess) { fprintf(stderr, "kernel_launch: hipFuncSetAttribute failed\n"); grid = -1; return; }
        hipOccupancyMaxActiveBlocksPerMultiprocessor(&per_cu, (const void*)mega, 512, LDS_BYTES);
        if (per_cu < 1) { fprintf(stderr, "kernel_launch: occupancy query says %d blocks per CU\n", per_cu); per_cu = 1; }
        (void)hipGetLastError();
        grid = cus;
    }
    if (grid < 0) return;
    hipMemsetAsync((unsigned char*)d_ws + WS_CTL, 0, 16384, stream);
    P p{};
    for (int i = 0; i < 18; ++i) p.in[i] = (const float*)d_in[i];
    p.out = (float*)d_out; p.ws = (unsigned char*)d_ws;
#ifndef MK_MULTI
    p.ph_lo = 0; p.ph_hi = NPHASE;
    void* args[] = {&p};
    hipError_t e = hipLaunchCooperativeKernel((const void*)mega, dim3(grid), dim3(512), args, LDS_BYTES, stream);
    if (e != hipSuccess) fprintf(stderr, "cooperative launch failed: %s (grid %d)\n", hipGetErrorString(e), grid);
#else
    for (int ph = 0; ph < NPHASE; ++ph) { p.ph_lo = ph; p.ph_hi = ph + 1; hipLaunchKernelGGL(mega, dim3(grid), dim3(512), LDS_BYTES, stream, p); }
#endif
}
```

```cpp
#include <hip/hip_runtime.h>
#include <hip/hip_cooperative_groups.h>
#include <cstdio>
namespace cg = cooperative_groups;
namespace pg8 {
#define PG8_LAS __attribute__((address_space(3)))
typedef unsigned short bf16_t;
typedef short bf16x8 __attribute__((ext_vector_type(8)));
typedef float f32x4 __attribute__((ext_vector_type(4)));
typedef unsigned u32x4 __attribute__((ext_vector_type(4)));
constexpr int BM = 256, BK = 64, HALF = 128, HTB = HALF * BK * 2  , STAGE_BYTES = 8 * HTB, NXCD = 8, WGM = 8;

__host__ __device__ __forceinline__ int lds_byte(int r, int c) { const int st = (r >> 4) * 2 + (c >> 5), rr = r & 15, cc = c & 31, ob = rr * 64 + cc * 2; return st * 1024 + (ob ^ (((ob >> 9) & 1) << 5)); }
__host__ __device__ __forceinline__ void stage_rc(int b, int& R, int& C) { const int st = b / 1024, sb = b % 1024, swz = sb ^ (((sb >> 9) & 1) << 5); R = (st >> 1) * 16 + swz / 64; C = (st & 1) * 32 + (swz % 64) / 2; }
__host__ __device__ __forceinline__ int perm32(int rho) { const int n = rho >> 4, i = rho & 15; return 8 * (i >> 2) + 4 * n + (i & 3); }

struct Unit { int pm, pn, kp; };
struct Gemm { const bf16_t* A; const bf16_t* Bt; int M, N, K, xonly, lda, ldb; };
__host__ __device__ __forceinline__ int rowbase(int pm, int xonly) { return xonly ? (pm >> 4) * 4224 + 128 + (pm & 15) * 256 : pm * 256; }

struct StaticOrder {
    int nM, nN, nwg, G, c;
    __host__ __device__ void init(int M, int N, int G_, int c_) { nM = M / BM; nN = N / BM; nwg = nM * nN; G = G_; c = c_; }
    __host__ __device__ bool next(int i, Unit& u) const {
        const long L = (long)i * G + c; if (L >= nwg) return false;
        int wgid = (int)L; { const int q = nwg / NXCD, r = nwg % NXCD, xcd = wgid % NXCD, off = wgid / NXCD; wgid = (xcd < r ? xcd * (q + 1) : r * (q + 1) + (xcd - r) * q) + off; }
        const int nig = WGM * nN, gid = wgid / nig, fm = gid * WGM, gsz = (nM - fm) < WGM ? (nM - fm) : WGM;
        u.pm = fm + ((wgid % nig) % gsz); u.pn = (wgid % nig) / gsz; u.kp = 0; return true;
    }
    __device__ __forceinline__ void a_ready(const Unit&) const {}
    __device__ __forceinline__ void done(const Unit&) const {}
};
struct TailOrder {
    int npieces, nk, pm0, G, c;
    __device__ __forceinline__ bool next(int i, Unit& u) const { const int L = i * G + c; if (L >= npieces) return false; const int tile = L / nk; u.kp = L - tile * nk; u.pm = pm0 + (tile >> 2); u.pn = tile & 3; return true; }
    __device__ __forceinline__ void a_ready(const Unit&) const {}
    __device__ __forceinline__ void done(const Unit&) const {}
};
template <class Epi, class Sched, bool STAMP = false>
__device__ __forceinline__ void gemm_phase(PG8_LAS unsigned char* lds, const Gemm g, const Sched& S, const Epi& E, unsigned long long* stamps) {
    int tid_ = threadIdx.x; asm volatile("" : "+v"(tid_)); const int tid = tid_, wid = __builtin_amdgcn_readfirstlane(tid >> 6), lane = tid & 63, wr = wid >> 2, wc = wid & 3, fr = lane & 15, fq = lane >> 4;
    const int K = g.K, nt = K / BK;
    int ts_lo = 0, ts_hi = 0, nts = 0; const unsigned long long rt_entry = STAMP ? (unsigned long long)wall_clock64() : 0ull;
#define PG8_STAMP() do { if (STAMP && wid == 0 && nts < 64) { const unsigned long long _c = (unsigned long long)clock64(); \
        ts_lo = (lane == nts) ? (int)(unsigned)_c : ts_lo; ts_hi = (lane == nts) ? (int)(unsigned)(_c >> 32) : ts_hi; ++nts; } } while (0)
    PG8_STAMP();
    unsigned voffA[2], voffB[2];
#pragma unroll
    for (int i = 0; i < 2; ++i) { int R, C; stage_rc(tid * 16 + i * 8192, R, C); const int Rb = Epi::PERM ? ((R & ~31) + perm32(R & 31)) : R;
        voffA[i] = (unsigned)(R * g.lda + C) * 2u; voffB[i] = (unsigned)(Rb * g.ldb + C) * 2u; }
    const size_t kstep = (size_t)(BK * 2);
    const size_t hstep = (size_t)HALF * g.ldb * 2;
    const size_t tstep = 2 * hstep;
    const size_t hstepA = (size_t)HALF * g.lda * 2;
    const unsigned ldsw = (unsigned)wid * 1024u;
    const int aoff = lds_byte(wr * 64 + fr, fq * 8), boff = lds_byte(wc * 32 + fr, fq * 8);
#define PG8_SA(b, h) (((b) * 2 + (h)) * HTB)
#define PG8_SB(b, h) ((4 + (b) * 2 + (h)) * HTB)
#define PG8_STAGE(bufoff, gbase, voff) do { _Pragma("unroll") for (int _i = 0; _i < 2; ++_i) \
        __builtin_amdgcn_global_load_lds((const unsigned*)((const char*)(gbase) + (voff)[_i]), (PG8_LAS unsigned*)(lds + (bufoff) + ldsw + _i * 8192), 16, 0, 0); } while (0)
#define PG8_LDA(dst, b, h) do { _Pragma("unroll") for (int m = 0; m < 4; ++m) _Pragma("unroll") for (int k = 0; k < 2; ++k) dst[m][k] = *(const PG8_LAS bf16x8*)(lds + PG8_SA(b, h) + aoff + m * 2048 + k * 1024); } while (0)
#define PG8_LDB(dst, b, h) do { _Pragma("unroll") for (int n = 0; n < 2; ++n) _Pragma("unroll") for (int k = 0; k < 2; ++k) dst[n][k] = *(const PG8_LAS bf16x8*)(lds + PG8_SB(b, h) + boff + n * 2048 + k * 1024); } while (0)
#define PG8_MMA(ai, bj, At, Bt) do { __builtin_amdgcn_s_setprio(1); _Pragma("unroll") for (int m = 0; m < 4; ++m) _Pragma("unroll") for (int n = 0; n < 2; ++n) _Pragma("unroll") for (int k = 0; k < 2; ++k) \
        acc[ai][bj][m][n] = __builtin_amdgcn_mfma_f32_16x16x32_bf16(Bt[n][k], At[m][k], acc[ai][bj][m][n], 0, 0, 0); __builtin_amdgcn_s_setprio(0); } while (0)
#define PG8_WAIT_V(n) asm volatile("s_waitcnt vmcnt(" #n ")" ::: "memory")
#define PG8_WAIT_L(n) asm volatile("s_waitcnt lgkmcnt(" #n ")" ::: "memory")
#define PG8_BAR __builtin_amdgcn_s_barrier()
#define PG8_SCHED __builtin_amdgcn_sched_barrier(0)
    Unit cur, nxt; int ui = 0;
    if (!S.next(0, cur)) return;
    f32x4 acc[2][2][4][2];
#pragma unroll
    for (int a = 0; a < 2; ++a)
#pragma unroll
        for (int b = 0; b < 2; ++b)
#pragma unroll
            for (int m = 0; m < 4; ++m)
#pragma unroll
                for (int n = 0; n < 2; ++n) acc[a][b][m][n] = (f32x4){0.f, 0.f, 0.f, 0.f};
    bf16x8 At[4][2], B0[2][2], B1[2][2];
    const size_t rstep = (size_t)g.lda * 2;
    const char* cA = (const char*)g.A + (size_t)rowbase(cur.pm, g.xonly) * rstep + (size_t)cur.kp * K * 2; const char* cB = (const char*)g.Bt + (size_t)cur.pn * tstep + (size_t)cur.kp * K * 2;
    S.a_ready(cur);
    PG8_STAGE(PG8_SB(0, 0), cB, voffB); PG8_STAGE(PG8_SA(0, 0), cA, voffA); PG8_STAGE(PG8_SB(0, 1), cB + hstep, voffB); PG8_STAGE(PG8_SA(0, 1), cA + hstepA, voffA);
    if (wr == 1) PG8_BAR;
    PG8_WAIT_V(4); PG8_BAR;
    PG8_STAGE(PG8_SB(1, 0), cB + kstep, voffB); PG8_STAGE(PG8_SA(1, 0), cA + kstep, voffA); PG8_STAGE(PG8_SB(1, 1), cB + hstep + kstep, voffB);
    PG8_WAIT_V(6); PG8_BAR;
    PG8_STAMP();
    for (;;) {
        const bool has_next = S.next(ui + 1, nxt);
        const char* nA = has_next ? (const char*)g.A + (size_t)rowbase(nxt.pm, g.xonly) * rstep + (size_t)nxt.kp * K * 2 : cA; const char* nB = has_next ? (const char*)g.Bt + (size_t)nxt.pn * tstep + (size_t)nxt.kp * K * 2 : cB;
        for (int t = 0; t < nt; t += 2) {
            const bool last = (t == nt - 2);
            const char* a1 = cA + (size_t)(t + 1) * kstep;
            const char* a2 = last ? nA : cA + (size_t)(t + 2) * kstep; const char* b2 = last ? nB : cB + (size_t)(t + 2) * kstep;
            const char* a3 = a2 + kstep; const char* b3 = b2 + kstep;
            if (last && has_next) S.a_ready(nxt);
            PG8_LDB(B0, 0, 0); PG8_SCHED; PG8_LDA(At, 0, 0); PG8_STAGE(PG8_SA(1, 1), a1 + hstepA, voffA);
            PG8_WAIT_L(8); PG8_BAR; PG8_WAIT_L(0); PG8_MMA(0, 0, At, B0); PG8_BAR; PG8_SCHED;
            PG8_LDB(B1, 0, 1); PG8_STAGE(PG8_SB(0, 0), b2, voffB);
            PG8_BAR; PG8_WAIT_L(0); PG8_MMA(0, 1, At, B1); PG8_BAR;
            PG8_LDA(At, 0, 1); PG8_STAGE(PG8_SA(0, 0), a2, voffA);
            PG8_BAR; PG8_WAIT_L(0); PG8_MMA(1, 0, At, B0); PG8_BAR; PG8_SCHED;
            PG8_STAGE(PG8_SB(0, 1), b2 + hstep, voffB);
            PG8_WAIT_V(6); PG8_BAR; PG8_MMA(1, 1, At, B1); PG8_BAR;
            PG8_LDB(B0, 1, 0); PG8_SCHED; PG8_LDA(At, 1, 0); PG8_STAGE(PG8_SA(0, 1), a2 + hstepA, voffA);
            PG8_WAIT_L(8); PG8_BAR; PG8_WAIT_L(0); PG8_MMA(0, 0, At, B0); PG8_BAR; PG8_SCHED;
            PG8_LDB(B1, 1, 1); PG8_STAGE(PG8_SB(1, 0), b3, voffB);
            PG8_BAR; PG8_WAIT_L(0); PG8_MMA(0, 1, At, B1); PG8_BAR;
            PG8_LDA(At, 1, 1); PG8_STAGE(PG8_SA(1, 0), a3, voffA);
            PG8_BAR; PG8_WAIT_L(0); PG8_MMA(1, 0, At, B0); PG8_BAR; PG8_SCHED;
            PG8_STAGE(PG8_SB(1, 1), b3 + hstep, voffB);
            PG8_WAIT_V(6); PG8_BAR; PG8_MMA(1, 1, At, B1); PG8_BAR;
        }
        PG8_STAMP();
        if constexpr (!Epi::AFTER_DRAIN) { E(acc, cur, wr, wc, fr, fq); S.done(cur); }
        PG8_STAMP();
        if (!has_next) break;
#pragma unroll
        for (int a = 0; a < 2; ++a)
#pragma unroll
            for (int b = 0; b < 2; ++b)
#pragma unroll
                for (int m = 0; m < 4; ++m)
#pragma unroll
                    for (int n = 0; n < 2; ++n) acc[a][b][m][n] = (f32x4){0.f, 0.f, 0.f, 0.f};
        cur = nxt; cA = nA; cB = nB; ++ui;
    }
    PG8_WAIT_V(0);
    if (wr == 0) PG8_BAR;
    PG8_BAR;
    if constexpr (Epi::AFTER_DRAIN) { E.fused(acc, cur, wr, wc, fr, fq, lds, wid, lane); S.done(cur); }
    PG8_STAMP();
    if (STAMP && wid == 0) { stamps[lane] = lane < nts ? (((unsigned long long)(unsigned)ts_hi << 32) | (unsigned)ts_lo) : 0ull;
        if (lane == 62) stamps[62] = rt_entry; if (lane == 63) stamps[63] = (unsigned long long)wall_clock64(); }
#undef PG8_STAMP
#undef PG8_SA
#undef PG8_SB
#undef PG8_STAGE
#undef PG8_LDA
#undef PG8_LDB
#undef PG8_MMA
#undef PG8_WAIT_V
#undef PG8_WAIT_L
#undef PG8_BAR
#undef PG8_SCHED
}
}

using pg8::bf16_t; using pg8::bf16x8; using pg8::f32x4; using pg8::u32x4;
typedef float f32x16 __attribute__((ext_vector_type(16)));
typedef float f32x2v __attribute__((ext_vector_type(2)));
typedef __bf16 bf2v __attribute__((ext_vector_type(2)));
typedef unsigned u32x2 __attribute__((ext_vector_type(2)));
#define DI __device__ __forceinline__
#define MFMA32(a, b, c) __builtin_amdgcn_mfma_f32_32x32x16_bf16((a), (b), (c), 0, 0, 0)

constexpr int NB = 8, SEQ = 4096, PADF = 112, XOFF = 128, TT = 4224, MROWS = NB * TT, DM = 1024, DFF = 4096;
constexpr int N0 = 3840, N1 = 4096, LD1 = 4160, NCH = TT / 64;
constexpr float DN_ALPHA = 1.4142135623730951f;
constexpr int LDS_BYTES = 153600;
constexpr int SB_ITEMS = 129 * 64;
constexpr int TAIL0 = 32768;

constexpr size_t WS_CTL = 0;
constexpr size_t WS_WAB = 16384;
constexpr size_t WS_WABO = WS_WAB + (size_t)N0 * 1024 * 2;
constexpr size_t WS_WC = WS_WABO + (size_t)1024 * 1024 * 2;
constexpr size_t WS_WCO = WS_WC + (size_t)4096 * 1024 * 2;
constexpr size_t WS_W1 = WS_WCO + (size_t)1024 * 1024 * 2;
constexpr size_t WS_W2 = WS_W1 + (size_t)2 * 4096 * 1024 * 2;
constexpr size_t WS_H16 = WS_W2 + (size_t)2 * 4096 * 1024 * 2;
constexpr size_t WS_R1 = WS_H16 + (size_t)MROWS * 1024 * 2;
constexpr size_t WS_MIX = WS_R1 + (size_t)MROWS * LD1 * 2;
constexpr size_t WS_SIDE = WS_MIX + (size_t)MROWS * 1024 * 2;
constexpr size_t WS_KDT = WS_SIDE + (size_t)NB * 128 * 1024 * 4;
constexpr size_t WS_GA = WS_KDT + (size_t)MROWS * 512 * 2;
constexpr size_t WS_GT = WS_GA + (size_t)MROWS * 256 * 2;
constexpr size_t WS_END = WS_GT + 16384;
constexpr size_t DO_W = 0, DO_QD = (size_t)MROWS * 512 * 2, DO_UT = 2 * DO_QD;
constexpr size_t DO_HA = 0, DO_DVEC = (size_t)NB * 8 * NCH * 4096 * 2;

struct P { const float* in[18]; float* out; unsigned char* ws; int ph_lo, ph_hi; };

DI int my_tid() { int t = threadIdx.x; asm volatile("" : "+v"(t)); return t; }
DI float bf2f(unsigned short b) { return __uint_as_float(((unsigned)b) << 16); }
DI unsigned pack2(float lo, float hi) { f32x2v v = {lo, hi}; bf2v b = __builtin_convertvector(v, bf2v); return __builtin_bit_cast(unsigned, b); }
DI unsigned short f2bf(float x) { return (unsigned short)(pack2(x, 0.f) & 0xffffu); }
DI int crow(int reg, int h) { return (reg & 3) + 8 * (reg >> 2) + 4 * h; }
DI float sigmoidf_(float x) { return __builtin_amdgcn_rcpf(1.f + __expf(-x)); }
DI float siluf_(float x) { return x * __builtin_amdgcn_rcpf(1.f + __expf(-x)); }
DI float softplusf_(float x) { return fmaxf(x, 0.f) + __logf(1.f + __expf(-fabsf(x))); }
DI float lo16(unsigned u) { return __uint_as_float(u << 16); }
DI float hi16(unsigned u) { return __uint_as_float(u & 0xffff0000u); }
DI bf16x8 pack8(const f32x16& x, int s) {
    u32x4 p;
    p[0] = pack2(x[8 * s + 0], x[8 * s + 1]); p[1] = pack2(x[8 * s + 2], x[8 * s + 3]);
    p[2] = pack2(x[8 * s + 4], x[8 * s + 5]); p[3] = pack2(x[8 * s + 6], x[8 * s + 7]);
    return __builtin_bit_cast(bf16x8, p);
}
DI bf16x8 loadA(const bf16_t* p) {
    u32x2 a = *(const u32x2*)p, b = *(const u32x2*)(p + 8);
    u32x4 v = {a[0], a[1], b[0], b[1]};
    return __builtin_bit_cast(bf16x8, v);
}
DI float* yrow(float* dout, float* side, int row) {
    const int b = row / TT, pos = row - b * TT;
    return pos >= XOFF ? dout + ((size_t)b * SEQ + (pos - XOFF)) * DM : side + ((size_t)b * XOFF + pos) * DM;
}

struct EpiStore {
    static constexpr bool PERM = true, AFTER_DRAIN = false;
    bf16_t* O; int ldc; int act; int xonly; int sl, sh;
    DI void operator()(const f32x4 (&acc)[2][2][4][2], const pg8::Unit& u, int wr, int wc, int fr, int fq) const {
        const int row0 = pg8::rowbase(u.pm, xonly) + wr * 64 + fr, col0 = u.pn * 256 + wc * 32 + 8 * fq;
        const bool gate = u.pn >= sl && u.pn < sh;
#pragma unroll
        for (int ai = 0; ai < 2; ++ai)
#pragma unroll
            for (int m = 0; m < 4; ++m) {
                bf16_t* rowp = O + (size_t)(row0 + ai * 128 + m * 16) * ldc + col0;
#pragma unroll
                for (int bj = 0; bj < 2; ++bj) {
                    f32x4 v0 = acc[ai][bj][m][0], v1 = acc[ai][bj][m][1];
                    if (act) {
#pragma unroll
                        for (int e = 0; e < 4; ++e) { float a = fmaxf(v0[e], 0.f), b = fmaxf(v1[e], 0.f); v0[e] = a * a; v1[e] = b * b; }
                    }
                    if (gate) {
#pragma unroll
                        for (int e = 0; e < 4; ++e) { v0[e] = siluf_(v0[e]); v1[e] = siluf_(v1[e]); }
                    }
                    u32x4 o = {pack2(v0[0], v0[1]), pack2(v0[2], v0[3]), pack2(v1[0], v1[1]), pack2(v1[2], v1[3])};
                    __builtin_nontemporal_store(o, (u32x4*)(rowp + bj * 128));
                }
            }
    }
};
struct EpiResid {
    static constexpr bool PERM = true, AFTER_DRAIN = false;
    const bf16_t* H; bf16_t* Y; int xonly;
    DI void operator()(const f32x4 (&acc)[2][2][4][2], const pg8::Unit& u, int wr, int wc, int fr, int fq) const {
        const int row0 = pg8::rowbase(u.pm, xonly) + wr * 64 + fr, col0 = u.pn * 256 + wc * 32 + 8 * fq;
#pragma unroll
        for (int ai = 0; ai < 2; ++ai)
#pragma unroll
            for (int m = 0; m < 4; ++m) {
                const size_t ro = (size_t)(row0 + ai * 128 + m * 16) * DM + col0;
#pragma unroll
                for (int bj = 0; bj < 2; ++bj) {
                    const u32x4 hv = *(const u32x4*)(H + ro + bj * 128);
                    const f32x4 v0 = acc[ai][bj][m][0], v1 = acc[ai][bj][m][1];
                    u32x4 o = {pack2(DN_ALPHA * lo16(hv[0]) + v0[0], DN_ALPHA * hi16(hv[0]) + v0[1]), pack2(DN_ALPHA * lo16(hv[1]) + v0[2], DN_ALPHA * hi16(hv[1]) + v0[3]),
                               pack2(DN_ALPHA * lo16(hv[2]) + v1[0], DN_ALPHA * hi16(hv[2]) + v1[1]), pack2(DN_ALPHA * lo16(hv[3]) + v1[2], DN_ALPHA * hi16(hv[3]) + v1[3])};
                    *(u32x4*)(Y + ro + bj * 128) = o;
                }
            }
    }
};

struct EpiPart {
    static constexpr bool PERM = false, AFTER_DRAIN = false;
    float* slab; int row_origin;
    DI void operator()(const f32x4 (&acc)[2][2][4][2], const pg8::Unit& u, int wr, int wc, int fr, int fq) const {
        const int row0 = u.pm * 256 - row_origin + wr * 64 + fr, col0 = u.pn * 256 + wc * 32 + 4 * fq;
#pragma unroll
        for (int ai = 0; ai < 2; ++ai)
#pragma unroll
            for (int m = 0; m < 4; ++m) {
                float* rp = slab + ((size_t)u.kp * 1024 + (row0 + ai * 128 + m * 16)) * 1024 + col0;
#pragma unroll
                for (int bj = 0; bj < 2; ++bj)
#pragma unroll
                    for (int n = 0; n < 2; ++n) *(f32x4*)(rp + bj * 128 + n * 16) = acc[ai][bj][m][n];
            }
    }
};

DI void prep_phase(const P& p, unsigned char* lds, int part, int wid, int nwk) {
    float* tile = (float*)lds;
    const int tid = my_tid();
    constexpr int NT0 = 16 * 60, NT1 = 16 * 16, NT2 = 16 * 64, NT3 = 16 * 16, NT4 = 16 * 64, NT5 = 64 * 16;
    constexpr int C0 = NT0, C1 = C0 + NT1, C2 = C1 + NT2, C3 = C2 + NT3, C4 = C3 + 2 * NT4, C5 = C4 + 2 * NT5;
    const int npart = part == 0 ? C0 : (part == 1 ? (C2 - C0) + NT4 + NT5 : (C3 - C2) + NT4 + NT5);
    for (int j = wid; j < npart; j += nwk) {
        int tix;
        if (part == 0) tix = j;
        else if (part == 1) tix = j < (C2 - C0) ? C0 + j : (j < (C2 - C0) + NT4 ? C3 + (j - (C2 - C0)) : C4 + (j - (C2 - C0) - NT4));
        else tix = j < (C3 - C2) ? C2 + j : (j < (C3 - C2) + NT4 ? C3 + NT4 + (j - (C3 - C2)) : C4 + NT5 + (j - (C3 - C2) - NT4));
        const float* src; bf16_t* dst; int K, Ns, Nd, loc, remap = 0;
        if (tix < C0) { src = p.in[2]; dst = (bf16_t*)(p.ws + WS_WAB); K = 1024; Ns = 3592; Nd = N0; loc = tix; remap = 1; }
        else if (tix < C1) { src = p.in[7]; dst = (bf16_t*)(p.ws + WS_WABO); K = 1024; Ns = 1024; Nd = 1024; loc = tix - C0; }
        else if (tix < C2) { src = p.in[8]; dst = (bf16_t*)(p.ws + WS_WC); K = 1024; Ns = 4096; Nd = 4096; loc = tix - C1; }
        else if (tix < C3) { src = p.in[11]; dst = (bf16_t*)(p.ws + WS_WCO); K = 1024; Ns = 1024; Nd = 1024; loc = tix - C2; }
        else if (tix < C4) { int l = (tix - C3) / NT4; src = p.in[14] + (size_t)l * 1024 * 4096; dst = (bf16_t*)(p.ws + WS_W1) + (size_t)l * 4096 * 1024; K = 1024; Ns = 4096; Nd = 4096; loc = (tix - C3) % NT4; }
        else { int l = (tix - C4) / NT5; src = p.in[15] + (size_t)l * 4096 * 1024; dst = (bf16_t*)(p.ws + WS_W2) + (size_t)l * 1024 * 4096; K = 4096; Ns = 1024; Nd = 1024; loc = (tix - C4) % NT5; }
        const int ntn = Nd / 64, kt = loc / ntn, nt = loc % ntn, k0 = kt * 64, n0 = nt * 64;
#pragma unroll
        for (int it = 0; it < 2; ++it) {
            const int i = (tid >> 4) + 32 * it, j = (tid & 15) * 4, n = n0 + j;
            int ns = n; bool valid = true;
            if (remap) { if (n < 2048) ns = n; else if (n < 3584) ns = n + 8; else if (n < 3592) ns = n - 3584 + 2048; else valid = false; }
            f32x4 v = {0.f, 0.f, 0.f, 0.f};
            if (valid) v = *(const f32x4*)(src + (size_t)(k0 + i) * Ns + ns);
            tile[i * 65 + j] = v[0]; tile[i * 65 + j + 1] = v[1]; tile[i * 65 + j + 2] = v[2]; tile[i * 65 + j + 3] = v[3];
        }
        __syncthreads();
        {
            const int j = tid >> 3, i0 = (tid & 7) * 8;
            u32x4 o;
#pragma unroll
            for (int e = 0; e < 4; ++e) o[e] = pack2(tile[(i0 + 2 * e) * 65 + j], tile[(i0 + 2 * e + 1) * 65 + j]);
            *(u32x4*)(dst + (size_t)(n0 + j) * K + k0 + i0) = o;
        }
        __syncthreads();
    }
    if (part != 0) return;
    bf16_t* h16 = (bf16_t*)(p.ws + WS_H16);
    const float* x = p.in[0]; const float* meta = p.in[1];
    for (int uidx = blockIdx.x * 512 + tid; uidx < MROWS * 128; uidx += gridDim.x * 512) {
        const int row = uidx >> 7, c0 = (uidx & 127) * 8, b = row / TT, pos = row - b * TT;
        u32x4 o = {0u, 0u, 0u, 0u};
        if (pos >= PADF) {
            const float* s = pos >= XOFF ? x + ((size_t)b * SEQ + (pos - XOFF)) * DM + c0 : meta + (size_t)(pos - PADF) * DM + c0;
            const f32x4 a = *(const f32x4*)s, c = *(const f32x4*)(s + 4);
            o[0] = pack2(a[0], a[1]); o[1] = pack2(a[2], a[3]); o[2] = pack2(c[0], c[1]); o[3] = pack2(c[2], c[3]);
        }
        *(u32x4*)(h16 + (size_t)row * DM + c0) = o;
    }
}

DI float wave_sum(float v) {
#pragma unroll
    for (int o = 32; o >= 1; o >>= 1) v += __shfl_xor(v, o);
    return v;
}
DI void ln_phase(const P& p, const bf16_t* Y, const float* g, const float* bb, int xonly, int final_, int nk) {
    const int tid = my_tid(), lane = tid & 63, gw = blockIdx.x * 8 + (tid >> 6), nw = gridDim.x * 8;
    bf16_t* h16 = (bf16_t*)(p.ws + WS_H16);
    f32x4 gv[4], bv[4];
#pragma unroll
    for (int i = 0; i < 2; ++i) { gv[2 * i] = *(const f32x4*)(g + i * 512 + lane * 8); gv[2 * i + 1] = *(const f32x4*)(g + i * 512 + lane * 8 + 4);
                                  bv[2 * i] = *(const f32x4*)(bb + i * 512 + lane * 8); bv[2 * i + 1] = *(const f32x4*)(bb + i * 512 + lane * 8 + 4); }
    for (int row = gw; row < MROWS; row += nw) {
        const int b = row / TT, pos = row - b * TT;
        if (xonly && pos < XOFF) continue;
        const bf16_t* y = Y + (size_t)row * DM;
        float v[16]; float s = 0.f;
        if (nk > 0 && row >= TAIL0) {
#pragma unroll
            for (int i = 0; i < 2; ++i) {
                const u32x4 w = *(const u32x4*)(h16 + (size_t)row * DM + i * 512 + lane * 8);
#pragma unroll
                for (int e = 0; e < 4; ++e) { v[8 * i + 2 * e] = DN_ALPHA * lo16(w[e]); v[8 * i + 2 * e + 1] = DN_ALPHA * hi16(w[e]); }
            }
            for (int kp = 0; kp < nk; ++kp) {
                const float* sp = p.out + ((size_t)kp * 1024 + (row - TAIL0)) * 1024 + lane * 8;
#pragma unroll
                for (int i = 0; i < 2; ++i) {
                    const f32x4 a = *(const f32x4*)(sp + i * 512), c = *(const f32x4*)(sp + i * 512 + 4);
#pragma unroll
                    for (int e = 0; e < 4; ++e) { v[8 * i + e] += a[e]; v[8 * i + 4 + e] += c[e]; }
                }
            }
        } else {
#pragma unroll
            for (int i = 0; i < 2; ++i) {
                const u32x4 w = *(const u32x4*)(y + i * 512 + lane * 8);
#pragma unroll
                for (int e = 0; e < 4; ++e) { v[8 * i + 2 * e] = lo16(w[e]); v[8 * i + 2 * e + 1] = hi16(w[e]); }
            }
        }
#pragma unroll
        for (int e = 0; e < 16; ++e) s += v[e];
        const float mean = wave_sum(s) * (1.f / 1024.f);
        float q = 0.f;
#pragma unroll
        for (int e = 0; e < 16; ++e) { const float d = v[e] - mean; q += d * d; }
        const float rstd = rsqrtf(wave_sum(q) * (1.f / 1024.f) + 1e-5f);
        float o[16];
#pragma unroll
        for (int e = 0; e < 16; ++e) o[e] = (v[e] - mean) * rstd * gv[e >> 2][e & 3] + bv[e >> 2][e & 3];
        if (final_) {
            float* dst = p.out + ((size_t)b * SEQ + (pos - XOFF)) * DM;
#pragma unroll
            for (int i = 0; i < 2; ++i) { *(f32x4*)(dst + i * 512 + lane * 8) = (f32x4){o[8 * i], o[8 * i + 1], o[8 * i + 2], o[8 * i + 3]};
                                          *(f32x4*)(dst + i * 512 + lane * 8 + 4) = (f32x4){o[8 * i + 4], o[8 * i + 5], o[8 * i + 6], o[8 * i + 7]}; }
        } else {
#pragma unroll
            for (int i = 0; i < 2; ++i) {
                u32x4 w = {pack2(o[8 * i], o[8 * i + 1]), pack2(o[8 * i + 2], o[8 * i + 3]), pack2(o[8 * i + 4], o[8 * i + 5]), pack2(o[8 * i + 6], o[8 * i + 7])};
                if (pos < PADF) w = (u32x4){0u, 0u, 0u, 0u};
                *(u32x4*)(h16 + (size_t)row * DM + i * 512 + lane * 8) = w;
            }
        }
    }
}

DI void gdn_prep_item(const P& p, int item, unsigned char* lds) {
#ifdef PROBE3
    unsigned long long p3t = __builtin_amdgcn_s_memrealtime(), p3acc = 0ull;
#endif
    const int tid = my_tid(), lane = tid & 63, wv = tid >> 6, r = lane & 31, hh = lane >> 5;
    const int n = item % NCH, hb = item / NCH, h = hb & 3, b = hb >> 2;
    const int row0 = b * TT + n * 64;
    const bf16_t* proj = (const bf16_t*)(p.ws + WS_R1);
    bf16_t* qs = (bf16_t*)lds;
    bf16_t* ks = qs + 64 * 136;
    bf16_t* vbT = ks + 64 * 136;
    bf16_t* kbT = vbT + 128 * 72;
    bf16_t* kdTs = kbT + 128 * 72;
    bf16_t* Tm = kdTs + 128 * 72;
    float* Mm = (float*)(Tm + 64 * 72);
    float* gcs = Mm + 64 * 64; float* betas = gcs + 64;
    float* fac = (float*)(lds + 137216);
    bf16_t* Wg = (bf16_t*)((unsigned char*)p.out + DO_W); bf16_t* QD = (bf16_t*)((unsigned char*)p.out + DO_QD); bf16_t* UT = (bf16_t*)((unsigned char*)p.out + DO_UT);
    bf16_t* KDT = (bf16_t*)(p.ws + WS_KDT); bf16_t* GA = (bf16_t*)(p.ws + WS_GA); float* GT = (float*)(p.ws + WS_GT);
    const float* conv_w = p.in[3];
    bf16_t* vs = Tm;
    {
        const int seg = tid / 48, g48 = tid - seg * 48, part = g48 >> 4, c0 = (g48 & 15) * 8;
        const int ch = part * 512 + h * 128 + c0, pos0 = n * 64 + seg * 8;
        if (tid < 384) {
            u32x4 xr[11]; f32x4 wg[8];
#pragma unroll
            for (int j = 0; j < 11; ++j) {
                const int pp = pos0 - 3 + j;
                xr[j] = (u32x4){0u, 0u, 0u, 0u};
                if (pp >= 0) xr[j] = *(const u32x4*)(proj + (size_t)(b * TT + pp) * N0 + ch);
            }
#pragma unroll
            for (int k = 0; k < 4; ++k) { wg[2 * k] = *(const f32x4*)(conv_w + k * 1536 + ch); wg[2 * k + 1] = *(const f32x4*)(conv_w + k * 1536 + ch + 4); }
            bf16_t* dst = (part == 0 ? qs : (part == 1 ? ks : vs)) + c0;
#pragma unroll
            for (int tt = 0; tt < 8; ++tt) {
                float acc[8];
#pragma unroll
                for (int e = 0; e < 8; ++e) acc[e] = 0.f;
#pragma unroll
                for (int k = 0; k < 4; ++k) {
                    const u32x4 xv = xr[tt + k]; const f32x4 w0 = wg[2 * k], w1 = wg[2 * k + 1];
                    acc[0] += w0[0] * lo16(xv[0]); acc[1] += w0[1] * hi16(xv[0]); acc[2] += w0[2] * lo16(xv[1]); acc[3] += w0[3] * hi16(xv[1]);
                    acc[4] += w1[0] * lo16(xv[2]); acc[5] += w1[1] * hi16(xv[2]); acc[6] += w1[2] * lo16(xv[3]); acc[7] += w1[3] * hi16(xv[3]);
                }
                float ss = 0.f;
#pragma unroll
                for (int e = 0; e < 8; ++e) { acc[e] = siluf_(acc[e]); ss += acc[e] * acc[e]; }
                ss += __shfl_xor(ss, 1); ss += __shfl_xor(ss, 2); ss += __shfl_xor(ss, 4); ss += __shfl_xor(ss, 8);
                const float sc = part == 2 ? 1.f : rsqrtf(ss + 1e-6f) * (part == 0 ? 0.08838834764831845f : 1.f);
                u32x4 o = {pack2(acc[0] * sc, acc[1] * sc), pack2(acc[2] * sc, acc[3] * sc), pack2(acc[4] * sc, acc[5] * sc), pack2(acc[6] * sc, acc[7] * sc)};
                *(u32x4*)(dst + (seg * 8 + tt) * 136) = o;
            }
        } else if (tid >= 448) {
            const int t = tid - 448;
            const size_t ro = (size_t)(row0 + t) * N0;
            const float ba = bf2f(proj[ro + 3584 + h]), aa = bf2f(proj[ro + 3588 + h]);
            const float beta = sigmoidf_(ba);
            float g = -__expf(p.in[4][h]) * softplusf_(aa + p.in[5][h]);
#pragma unroll
            for (int o = 1; o < 64; o <<= 1) { const float tv = __shfl_up(g, o); if (lane >= o) g += tv; }
            gcs[t] = g; betas[t] = beta;
            const float glw = __builtin_bit_cast(float, __builtin_amdgcn_readlane(__builtin_bit_cast(int, g), 63)), eg = __expf(g);
            fac[t] = eg; fac[64 + t] = beta * eg; fac[128 + t] = __expf(glw - g);
        }
    }
    __syncthreads();
    const float gl = gcs[63];
    if (tid == 0) GT[item] = __expf(gl);
#pragma unroll
    for (int it = 0; it < 2; ++it) {
        const int idx = it * 512 + tid, t = idx >> 4, c8 = (idx & 15) * 8;
        const u32x4 q8 = *(const u32x4*)(qs + t * 136 + c8);
        const float eg = fac[t];
        u32x4 o2 = {pack2(lo16(q8[0]) * eg, hi16(q8[0]) * eg), pack2(lo16(q8[1]) * eg, hi16(q8[1]) * eg), pack2(lo16(q8[2]) * eg, hi16(q8[2]) * eg), pack2(lo16(q8[3]) * eg, hi16(q8[3]) * eg)};
        *(u32x4*)(QD + (size_t)(row0 + t) * 512 + h * 128 + c8) = o2;
    }
#pragma unroll
    for (int it = 0; it < 6; ++it) {
        const int u = it * 512 + tid, arr = u >> 10, rem = u & 1023, c = rem & 127, t8 = (rem >> 7) * 8;
        const bf16_t* src = (arr < 2 ? ks : vs) + c;
        bf16_t* dstT = (arr == 0 ? kbT : (arr == 1 ? kdTs : vbT)) + c * 72 + t8;
        float v[8];
#pragma unroll
        for (int j = 0; j < 8; ++j) {
            const float f = arr == 0 ? fac[64 + t8 + j] : (arr == 1 ? fac[128 + t8 + j] : betas[t8 + j]);
            v[j] = bf2f(src[(t8 + j) * 136]) * f;
        }
        u32x4 o = {pack2(v[0], v[1]), pack2(v[2], v[3]), pack2(v[4], v[5]), pack2(v[6], v[7])};
        *(u32x4*)dstT = o;
    }
    __syncthreads();
    {
        const int which = wv >> 2, mi = (wv >> 1) & 1, ni = wv & 1;
        const bf16_t* Ap = (which ? qs : ks) + (32 * mi + r) * 136 + 8 * hh;
        const bf16_t* Bp = ks + (32 * ni + r) * 136 + 8 * hh;
        f32x16 acc;
#pragma unroll
        for (int j = 0; j < 16; ++j) acc[j] = 0.f;
#pragma unroll
        for (int s = 0; s < 8; ++s) acc = MFMA32(*(const bf16x8*)(Ap + 16 * s), *(const bf16x8*)(Bp + 16 * s), acc);
        const int jt = 32 * ni + r; const float gj = gcs[jt];
#pragma unroll
        for (int j = 0; j < 16; ++j) {
            const int i = 32 * mi + crow(j, hh);
            const float dec = __expf(fminf(gcs[i] - gj, 0.f));
            if (which == 0) Mm[i * 64 + jt] = (jt < i) ? betas[i] * acc[j] * dec : 0.f;
            else GA[(size_t)item * 4096 + i * 64 + jt] = f2bf((jt <= i) ? acc[j] * dec : 0.f);
        }
    }
    __syncthreads();
#ifdef PROBE3
    { const unsigned long long tq = __builtin_amdgcn_s_memrealtime(); if (PROBE3 == 3) p3acc += tq - p3t; p3t = tq; }
#endif
    float* Tf = (float*)(lds + 116224);
    float* Xs = Tf + 4096;
    if (wv == 0) {
        const int d = lane >> 5, c = lane & 31;
        const float* Mb = Mm + (32 * d) * 64 + 32 * d;
        float x[32];
        f32x4 mc[8], mn[8];
#pragma unroll
        for (int q = 0; q < 8; ++q) { mc[q] = (f32x4){0.f, 0.f, 0.f, 0.f}; mn[q] = mc[q]; }
#pragma unroll
        for (int i = 0; i < 32; ++i) {
            if (i + 1 < 32) {
#pragma unroll
                for (int q = 0; q < (i + 4) / 4; ++q) mn[q] = *(const f32x4*)(Mb + (i + 1) * 64 + 4 * q);
            }
            __builtin_amdgcn_sched_barrier(0);
            float a0 = (i == c) ? 1.f : 0.f, a1 = 0.f;
#pragma unroll
            for (int l = 0; l < i; ++l) { if (l & 1) a1 -= mc[l >> 2][l & 3] * x[l]; else a0 -= mc[l >> 2][l & 3] * x[l]; }
            x[i] = a0 + a1;
            __builtin_amdgcn_sched_barrier(0);
#pragma unroll
            for (int q = 0; q < 8; ++q) mc[q] = mn[q];
        }
#pragma unroll
        for (int i = 0; i < 32; ++i) Tf[(32 * d + i) * 64 + 32 * d + c] = x[i];
        if (d == 0) {
#pragma unroll
            for (int i = 0; i < 32; ++i) Tf[i * 64 + 32 + c] = 0.f;
        }
    }
    __syncthreads();
#ifdef PROBE3
    { const unsigned long long tq = __builtin_amdgcn_s_memrealtime(); if (PROBE3 == 4) p3acc += tq - p3t; p3t = tq; }
#endif
    {
        const int i = tid >> 4, j0 = (tid & 15) * 2;
        float x0 = 0.f, x1 = 0.f;
#pragma unroll
        for (int q = 0; q < 8; ++q) {
            const f32x4 m = *(const f32x4*)(Mm + (32 + i) * 64 + 4 * q);
#pragma unroll
            for (int e = 0; e < 4; ++e) { const f32x2v t = *(const f32x2v*)(Tf + (4 * q + e) * 64 + j0); x0 += m[e] * t[0]; x1 += m[e] * t[1]; }
        }
        Xs[i * 33 + j0] = x0; Xs[i * 33 + j0 + 1] = x1;
    }
    __syncthreads();
#ifdef PROBE3
    { const unsigned long long tq = __builtin_amdgcn_s_memrealtime(); if (PROBE3 == 5) p3acc += tq - p3t; p3t = tq; }
#endif
    {
        const int i = tid >> 4, j0 = (tid & 15) * 2;
        float x0 = 0.f, x1 = 0.f;
#pragma unroll
        for (int q = 0; q < 8; ++q) {
            const f32x4 m = *(const f32x4*)(Tf + (32 + i) * 64 + 32 + 4 * q);
#pragma unroll
            for (int e = 0; e < 4; ++e) { x0 += m[e] * Xs[(4 * q + e) * 33 + j0]; x1 += m[e] * Xs[(4 * q + e) * 33 + j0 + 1]; }
        }
        Tf[(32 + i) * 64 + j0] = -x0; Tf[(32 + i) * 64 + j0 + 1] = -x1;
    }
    __syncthreads();
#ifdef PROBE3
    { const unsigned long long tq = __builtin_amdgcn_s_memrealtime(); if (PROBE3 == 6) p3acc += tq - p3t; p3t = tq; }
#endif
    {
        const int row = tid >> 3, c0 = (tid & 7) * 8;
        const f32x4 t0 = *(const f32x4*)(Tf + row * 64 + c0), t1 = *(const f32x4*)(Tf + row * 64 + c0 + 4);
        u32x4 o = {pack2(t0[0], t0[1]), pack2(t0[2], t0[3]), pack2(t1[0], t1[1]), pack2(t1[2], t1[3])};
        *(u32x4*)(Tm + row * 72 + c0) = o;
    }
    __syncthreads();
#ifdef PROBE3
    { const unsigned long long tq = __builtin_amdgcn_s_memrealtime(); if (PROBE3 == 7) p3acc += tq - p3t; p3t = tq; }
#endif
    {
        const int dt = wv >> 1, it = wv & 1;
        f32x16 au, aw;
#pragma unroll
        for (int j = 0; j < 16; ++j) { au[j] = 0.f; aw[j] = 0.f; }
#pragma unroll
        for (int s = 0; s < 4; ++s) {
            const bf16x8 bT = *(const bf16x8*)(Tm + (32 * it + r) * 72 + 16 * s + 8 * hh);
            au = MFMA32(*(const bf16x8*)(vbT + (32 * dt + r) * 72 + 16 * s + 8 * hh), bT, au);
            aw = MFMA32(*(const bf16x8*)(kbT + (32 * dt + r) * 72 + 16 * s + 8 * hh), bT, aw);
        }
#pragma unroll
        for (int j = 0; j < 16; ++j) UT[(size_t)item * 8192 + (32 * dt + crow(j, hh)) * 64 + 32 * it + r] = f2bf(au[j]);
#pragma unroll
        for (int g = 0; g < 4; ++g) {
            u32x2 o = {pack2(-aw[4 * g], -aw[4 * g + 1]), pack2(-aw[4 * g + 2], -aw[4 * g + 3])};
            *(u32x2*)(Wg + (size_t)(row0 + 32 * it + r) * 512 + h * 128 + 32 * dt + 8 * g + 4 * hh) = o;
        }
    }
#pragma unroll
    for (int it = 0; it < 2; ++it) {
        const int c = it * 512 + tid, dk = c >> 3, t8 = (c & 7) * 8;
        *(u32x4*)(KDT + (size_t)item * 8192 + dk * 64 + t8) = *(const u32x4*)(kdTs + dk * 72 + t8);
    }
    __syncthreads();
#ifdef PROBE3
    { const unsigned long long tq = __builtin_amdgcn_s_memrealtime(); if (PROBE3 == 8) p3acc += tq - p3t; p3t = tq; }
#endif
#ifdef PROBE3
    if (threadIdx.x == 0 && blockIdx.x == 0) ((unsigned*)(p.ws + WS_CTL))[96] += (unsigned)p3acc;
#endif
}

struct HgIn { u32x4 i8a, i8b, q8a, q8b, f8a, f8b; };
DI void hg_prep_load(const P& p, int item, int tid, HgIn& in) {
    const int lane = tid & 63, wv = tid >> 6;
    const int n = item % NCH, hb = item / NCH, h = hb & 7, b = hb >> 3;
    const bf16_t* rp = (const bf16_t*)(p.ws + WS_R1) + (size_t)(b * TT + n * 64 + lane) * LD1 + h * 128 + 16 * wv;
    in.i8a = *(const u32x4*)(rp + 2048); in.i8b = *(const u32x4*)(rp + 2056);
    in.q8a = *(const u32x4*)rp; in.q8b = *(const u32x4*)(rp + 8);
    in.f8a = *(const u32x4*)(rp + 1024); in.f8b = *(const u32x4*)(rp + 1032);
}
DI void hg_prep_item(const P& p, int item, int next_item, unsigned char* lds, int tid, HgIn& in) {
    const int lane = tid & 63, wv = tid >> 6, r = lane & 31, hh = lane >> 5;
    const int n = item % NCH, hb = item / NCH, h = hb & 7, b = hb >> 3;
    const int row0 = b * TT + n * 64;
    bf16_t* proj = (bf16_t*)(p.ws + WS_R1);
    bf16_t* qs = (bf16_t*)lds;
    bf16_t* ks = qs + 64 * 136;
    bf16_t* HA = (bf16_t*)((unsigned char*)p.out + DO_HA); float* DVEC = (float*)((unsigned char*)p.out + DO_DVEC);
    const float* lbr = p.in[9];
    const int c0 = 16 * wv;
    bf16_t* rp = proj + (size_t)(row0 + lane) * LD1 + h * 128 + c0;
    const u32x4 i8a = in.i8a, i8b = in.i8b, q8a = in.q8a, q8b = in.q8b, f8a = in.f8a, f8b = in.f8b;
    float lf[16], kk[16], qq[16];
#pragma unroll
    for (int e = 0; e < 16; ++e) {
        const unsigned fw = (e < 8) ? f8a[(e & 7) >> 1] : f8b[(e & 7) >> 1], qw = (e < 8) ? q8a[(e & 7) >> 1] : q8b[(e & 7) >> 1];
        const float fv = (e & 1) ? hi16(fw) : lo16(fw), qv = (e & 1) ? hi16(qw) : lo16(qw);
        const float lb = ((const float*)(lds + 36864))[h * 128 + c0 + e];
        const float sg = sigmoidf_(fv);
        kk[e] = (1.f - lb) * (1.f - sg);
        lf[e] = 1.f - kk[e];
        qq[e] = siluf_(qv);
    }
    asm volatile("" :: "v"(i8a[3]), "v"(i8b[3]), "v"(q8b[3]), "v"(f8b[3]));
    if (next_item >= 0) hg_prep_load(p, next_item, tid, in);
    asm volatile("s_waitcnt lgkmcnt(0)\n\ts_barrier" ::: "memory");
#pragma unroll
    for (int e = 0; e < 16; ++e) {
        float x = lf[e];
        const int one = __builtin_bit_cast(int, 1.0f);
        x *= __builtin_bit_cast(float, __builtin_amdgcn_update_dpp(one, __builtin_bit_cast(int, x), 0x111, 0xf, 0xf, false));
        x *= __builtin_bit_cast(float, __builtin_amdgcn_update_dpp(one, __builtin_bit_cast(int, x), 0x112, 0xf, 0xf, false));
        x *= __builtin_bit_cast(float, __builtin_amdgcn_update_dpp(one, __builtin_bit_cast(int, x), 0x114, 0xf, 0xf, false));
        x *= __builtin_bit_cast(float, __builtin_amdgcn_update_dpp(one, __builtin_bit_cast(int, x), 0x118, 0xf, 0xf, false));
        const float r0 = __builtin_bit_cast(float, __builtin_amdgcn_readlane(__builtin_bit_cast(int, x), 15));
        const float r1 = __builtin_bit_cast(float, __builtin_amdgcn_readlane(__builtin_bit_cast(int, x), 31));
        const float r2 = __builtin_bit_cast(float, __builtin_amdgcn_readlane(__builtin_bit_cast(int, x), 47));
        x *= (lane >= 48) ? (r0 * r1 * r2) : (lane >= 32) ? (r0 * r1) : (lane >= 16) ? r0 : 1.f;
        lf[e] = x;
    }
    float qv[16], kh[16];
#pragma unroll
    for (int e = 0; e < 16; ++e) {
        const float ef = lf[e];
        const float ebl = __builtin_bit_cast(float, __builtin_amdgcn_readlane(__builtin_bit_cast(int, ef), 63));
        qv[e] = qq[e] * ef; kh[e] = kk[e] * __builtin_amdgcn_rcpf(ef);
        const int dk = c0 + e;
        bf16_t* dp = proj + (size_t)(row0 + (dk >> 1)) * LD1 + h * 128 + (dk & 1) * 64 + lane;
        dp[1024] = f2bf(kh[e] * ebl);
        const unsigned iw = (e < 8) ? i8a[(e & 7) >> 1] : i8b[(e & 7) >> 1];
        dp[2048] = (unsigned short)((e & 1) ? (iw >> 16) : (iw & 0xffffu));
        if (lane == 63) DVEC[(size_t)item * 128 + dk] = ebl;
    }
    {
        u32x4 qa = {pack2(qv[0], qv[1]), pack2(qv[2], qv[3]), pack2(qv[4], qv[5]), pack2(qv[6], qv[7])};
        u32x4 qb = {pack2(qv[8], qv[9]), pack2(qv[10], qv[11]), pack2(qv[12], qv[13]), pack2(qv[14], qv[15])};
        u32x4 ka = {pack2(kh[0], kh[1]), pack2(kh[2], kh[3]), pack2(kh[4], kh[5]), pack2(kh[6], kh[7])};
        u32x4 kb = {pack2(kh[8], kh[9]), pack2(kh[10], kh[11]), pack2(kh[12], kh[13]), pack2(kh[14], kh[15])};
        *(u32x4*)(qs + lane * 136 + c0) = qa; *(u32x4*)(qs + lane * 136 + c0 + 8) = qb;
        *(u32x4*)(ks + lane * 136 + c0) = ka; *(u32x4*)(ks + lane * 136 + c0 + 8) = kb;
        *(u32x4*)rp = qa; *(u32x4*)(rp + 8) = qb;
    }
    asm volatile("s_waitcnt lgkmcnt(0)\n\ts_barrier" ::: "memory");
    if (wv < 4) {
        const int mi = wv >> 1, ni = wv & 1;
        const bf16_t* Ap = qs + (32 * mi + r) * 136 + 8 * hh;
        const bf16_t* Bp = ks + (32 * ni + r) * 136 + 8 * hh;
        f32x16 acc;
#pragma unroll
        for (int j = 0; j < 16; ++j) acc[j] = 0.f;
#pragma unroll
        for (int s = 0; s < 8; ++s) acc = MFMA32(*(const bf16x8*)(Ap + 16 * s), *(const bf16x8*)(Bp + 16 * s), acc);
        const int jt = 32 * ni + r;
#pragma unroll
        for (int j = 0; j < 16; ++j) { const int i = 32 * mi + crow(j, hh); HA[(size_t)item * 4096 + i * 64 + jt] = f2bf((jt <= i) ? acc[j] : 0.f); }
    }
}

struct ScanPtrs { const bf16_t *qd, *wq, *Am, *kdT, *uT, *zg; const float *dvec, *gn; bf16_t* outp; int qld, zld; size_t cs; int s2; };
constexpr int SC_W = 0, SC_Q = 16896, SC_A = 33792, SC_K = 42496, SC_U = 59904, SC_O = 77312, SC_D = 144896, SC_G = 145408;
template <int KIND>
DI void scan_issue(const ScanPtrs& sp, int n, int lt, u32x4 (&rw)[4], u32x4 (&rq)[4], u32x4 (&ra)[2], u32x4 (&rk)[4], u32x4 (&ru)[4], f32x4& rd) {
    const int t0 = n * 64;
#pragma unroll
    for (int i = 0; i < 4; ++i) {
        const int c = i * 256 + lt, row = c >> 4, col = (c & 15) * 8;
        if (KIND == 0) rw[i] = *(const u32x4*)(sp.wq + (size_t)(t0 + row) * sp.qld + col);
        rq[i] = *(const u32x4*)(sp.qd + (size_t)(t0 + row) * sp.qld + col);
    }
#pragma unroll
    for (int i = 0; i < 2; ++i) { const int c = i * 256 + lt, row = c >> 3, col = (c & 7) * 8; ra[i] = *(const u32x4*)(sp.Am + (size_t)n * 4096 + row * 64 + col); }
#pragma unroll
    for (int i = 0; i < 4; ++i) {
        const int c = i * 256 + lt, dk = c >> 3, t8 = (c & 7) * 8;
        const size_t off = (size_t)n * sp.cs + (size_t)(dk >> 1) * sp.s2 + (dk & 1) * 64 + t8;
        rk[i] = *(const u32x4*)(sp.kdT + off); ru[i] = *(const u32x4*)(sp.uT + off);
    }
    if (lt < 32) { if (KIND == 0) { const float d = sp.dvec[n]; rd = (f32x4){d, d, d, d}; } else rd = *(const f32x4*)(sp.dvec + (size_t)n * 128 + lt * 4); }
}
DI void st16(bf16_t* p, const u32x4& v) { *(u32x2*)p = (u32x2){v[0], v[1]}; *(u32x2*)(p + 4) = (u32x2){v[2], v[3]}; }
template <int KIND>
DI void scan_fill(unsigned char* lds, int lt, const u32x4 (&rw)[4], const u32x4 (&rq)[4], const u32x4 (&ra)[2], const u32x4 (&rk)[4], const u32x4 (&ru)[4], const f32x4& rd) {
#pragma unroll
    for (int i = 0; i < 4; ++i) {
        const int c = i * 256 + lt, row = c >> 4, col = (c & 15) * 8;
        if (KIND == 0) st16((bf16_t*)(lds + SC_W) + row * 132 + col, rw[i]);
        st16((bf16_t*)(lds + SC_Q) + row * 132 + col, rq[i]);
    }
#pragma unroll
    for (int i = 0; i < 2; ++i) { const int c = i * 256 + lt, row = c >> 3, col = (c & 7) * 8; st16((bf16_t*)(lds + SC_A) + row * 68 + col, ra[i]); }
#pragma unroll
    for (int i = 0; i < 4; ++i) {
        const int c = i * 256 + lt, dk = c >> 3, t8 = (c & 7) * 8;
        st16((bf16_t*)(lds + SC_K) + dk * 68 + t8, rk[i]); st16((bf16_t*)(lds + SC_U) + dk * 68 + t8, ru[i]);
    }
    if (lt < 32) *(f32x4*)((float*)(lds + SC_D) + lt * 4) = rd;
}
DI void scan_zload(const ScanPtrs& sp, int m, int lt, u32x4 (&zr)[4]) {
    const int row = lt >> 2, c0 = (lt & 3) * 32;
    const bf16_t* zp = sp.zg + (size_t)(m * 64 + row) * sp.zld + c0;
#pragma unroll
    for (int i = 0; i < 4; ++i) zr[i] = *(const u32x4*)(zp + 8 * i);
}
DI void scan_epilogue(const ScanPtrs& sp, unsigned char* lds, int m, int lt, const u32x4 (&zr)[4]) {
    const int row = lt >> 2, c0 = (lt & 3) * 32;
    const float* ob = (const float*)(lds + SC_O) + (m & 1) * 64 * 132 + row * 132 + c0;
    const float* gl = (const float*)(lds + SC_G) + c0;
    float ss = 0.f;
#pragma unroll
    for (int i = 0; i < 8; ++i) { const f32x4 v = *(const f32x4*)(ob + 4 * i); ss += v[0] * v[0] + v[1] * v[1] + v[2] * v[2] + v[3] * v[3]; }
    ss += __shfl_xor(ss, 1); ss += __shfl_xor(ss, 2);
    const float inv = rsqrtf(ss * (1.f / 128.f) + 1e-6f);
    bf16_t* op = sp.outp + (size_t)(m * 64 + row) * DM + c0;
#pragma unroll
    for (int i = 0; i < 8; ++i) {
        const f32x4 g0 = *(const f32x4*)(gl + 4 * i);
        const f32x4 a = *(const f32x4*)(ob + 4 * i);
        const unsigned z0 = zr[i >> 1][(i & 1) * 2], z1 = zr[i >> 1][(i & 1) * 2 + 1];
        u32x2 o;
        o[0] = pack2(a[0] * inv * g0[0] * lo16(z0), a[1] * inv * g0[1] * hi16(z0));
        o[1] = pack2(a[2] * inv * g0[2] * lo16(z1), a[3] * inv * g0[3] * hi16(z1));
        *(u32x2*)(op + 4 * i) = o;
    }
}
template <int KIND>
DI void scan_chain(const P& p, int chain, unsigned char* lds) {
#if defined(PROBE2) && PROBE2 == 4
    const unsigned long long e0 = __builtin_amdgcn_s_memrealtime();
#endif
    const int tid = my_tid(), lane = tid & 63, wv = __builtin_amdgcn_readfirstlane(tid >> 6), r = lane & 31, hh = lane >> 5, lt = tid - 256;
    const int h = KIND == 0 ? (chain & 3) : (chain & 7), b = KIND == 0 ? (chain >> 2) : (chain >> 3);
    const size_t rb = (size_t)b * TT;
    const bf16_t* r1 = (const bf16_t*)(p.ws + WS_R1);
    ScanPtrs sp;
    if (KIND == 0) {
        sp.qd = (const bf16_t*)((unsigned char*)p.out + DO_QD) + rb * 512 + h * 128; sp.wq = (const bf16_t*)((unsigned char*)p.out + DO_W) + rb * 512 + h * 128; sp.qld = 512;
        sp.Am = (const bf16_t*)(p.ws + WS_GA) + (size_t)chain * NCH * 4096;
        sp.kdT = (const bf16_t*)(p.ws + WS_KDT) + (size_t)chain * NCH * 8192; sp.uT = (const bf16_t*)((unsigned char*)p.out + DO_UT) + (size_t)chain * NCH * 8192; sp.cs = 8192; sp.s2 = 128;
        sp.dvec = (const float*)(p.ws + WS_GT) + (size_t)chain * NCH; sp.zg = r1 + rb * N0 + 1536 + h * 128; sp.zld = N0; sp.gn = p.in[6];
    } else {
        sp.qd = r1 + rb * LD1 + h * 128; sp.wq = sp.qd; sp.qld = LD1;
        sp.Am = (const bf16_t*)((unsigned char*)p.out + DO_HA) + (size_t)chain * NCH * 4096;
        sp.kdT = r1 + rb * LD1 + 1024 + h * 128; sp.uT = r1 + rb * LD1 + 2048 + h * 128; sp.cs = (size_t)64 * LD1; sp.s2 = LD1;
        sp.dvec = (const float*)((unsigned char*)p.out + DO_DVEC) + (size_t)chain * NCH * 128; sp.zg = r1 + rb * LD1 + 3072 + h * 128; sp.zld = LD1; sp.gn = p.in[10];
    }
    sp.outp = (bf16_t*)(p.ws + WS_MIX) + rb * DM + h * 128;
    const bf16_t* Wl = (const bf16_t*)(lds + SC_W); const bf16_t* Ql = (const bf16_t*)(lds + SC_Q); const bf16_t* Al = (const bf16_t*)(lds + SC_A);
    const bf16_t* Kl = (const bf16_t*)(lds + SC_K); const bf16_t* Ul = (const bf16_t*)(lds + SC_U); const float* Dl = (const float*)(lds + SC_D);
    float* obuf = (float*)(lds + SC_O);
    u32x4 rwA[4], rqA[4], raA[2], rkA[4], ruA[4]; f32x4 rdA = {0.f, 0.f, 0.f, 0.f};
    if (wv >= 4) {
        if (lt < 32) *(f32x4*)((float*)(lds + SC_G) + lt * 4) = *(const f32x4*)(sp.gn + lt * 4);
        scan_issue<KIND>(sp, 1, lt, rwA, rqA, raA, rkA, ruA, rdA); scan_fill<KIND>(lds, lt, rwA, rqA, raA, rkA, ruA, rdA);
        scan_issue<KIND>(sp, 2, lt, rwA, rqA, raA, rkA, ruA, rdA);
    }
    __syncthreads();
    const int dv0 = 32 * wv;
#define SCHED __builtin_amdgcn_sched_barrier(0)
#define LBAR() asm volatile("s_waitcnt lgkmcnt(0)\n\ts_barrier" ::: "memory")
#define LW(f, base, half) do { _Pragma("unroll") for (int _i = 0; _i < 4; ++_i) f[_i] = loadA((base) + 32 * (((half) * 4 + _i) >> 1) + 16 * (_i & 1)); } while (0)
#define MS(acc, f, half) do { _Pragma("unroll") for (int _i = 0; _i < 4; ++_i) acc = MFMA32(f[_i], Sb[((half) * 4 + _i) >> 1][_i & 1], acc); } while (0)
#define LK(f, kt) do { _Pragma("unroll") for (int _i = 0; _i < 4; ++_i) f[_i] = loadA(Kl + (32 * (kt) + r) * 68 + 32 * (_i >> 1) + 16 * (_i & 1) + 4 * hh); \
                       _Pragma("unroll") for (int _g = 0; _g < 4; ++_g) dcy[_g] = *(const f32x4*)(Dl + 32 * (kt) + 8 * _g + 4 * hh); } while (0)
#define SU(kt, f) do { _Pragma("unroll") for (int _g = 0; _g < 4; ++_g) _Pragma("unroll") for (int _e = 0; _e < 4; ++_e) S[kt][4 * _g + _e] *= dcy[_g][_e]; \
                       _Pragma("unroll") for (int _i = 0; _i < 4; ++_i) S[kt] = MFMA32(f[_i], vb[_i >> 1][_i & 1], S[kt]); } while (0)
#if defined(PROBE2) && PROBE2 == 4
    if (KIND == 0 && threadIdx.x == 0 && blockIdx.x == 0) ((unsigned*)(p.ws + WS_CTL))[96] = (unsigned)(__builtin_amdgcn_s_memrealtime() - e0);
#endif
    if (wv < 4) {
        f32x16 S[4];
#pragma unroll
        for (int kt = 0; kt < 4; ++kt)
#pragma unroll
            for (int j = 0; j < 16; ++j) S[kt][j] = 0.f;
#ifdef PROBE_SEL
        unsigned long long tacc = 0ull;
#endif
#pragma unroll 1
        for (int n = 1; n < NCH; ++n) {
#ifdef PROBE_SEL
            const unsigned long long pt0 = __builtin_amdgcn_s_memrealtime();
#endif
            u32x4 zr[4];
            scan_zload(sp, n, tid, zr);
            bf16x8 f0[4], f1[4];
            f32x16 vn[2], o[2];
            f32x4 dcy[4];
            const bf16_t* w0 = Wl + r * 132 + 4 * hh; const bf16_t* w1 = Wl + (32 + r) * 132 + 4 * hh;
            const bf16_t* q0 = Ql + r * 132 + 4 * hh; const bf16_t* q1 = Ql + (32 + r) * 132 + 4 * hh;
            if (KIND == 0) { LW(f0, w0, 0); LW(f1, w0, 1); } else { LW(f0, q0, 0); LW(f1, q0, 1); }
            const bf16_t* up = Ul + (dv0 + r) * 68 + 4 * hh;
            if (KIND == 0) {
#pragma unroll
                for (int mt = 0; mt < 2; ++mt)
#pragma unroll
                    for (int g = 0; g < 4; ++g) {
                        const u32x2 raw = *(const u32x2*)(up + 32 * mt + 8 * g);
                        vn[mt][4 * g] = lo16(raw[0]); vn[mt][4 * g + 1] = hi16(raw[0]); vn[mt][4 * g + 2] = lo16(raw[1]); vn[mt][4 * g + 3] = hi16(raw[1]);
                    }
            }
            bf16x8 Sb[4][2];
#pragma unroll
            for (int kt = 0; kt < 4; ++kt) { Sb[kt][0] = pack8(S[kt], 0); Sb[kt][1] = pack8(S[kt], 1); }
            SCHED;
            if (KIND == 0) {
                MS(vn[0], f0, 0); SCHED; LW(f0, w1, 0); SCHED; MS(vn[0], f1, 1);
                SCHED; LW(f1, w1, 1); SCHED;
                MS(vn[1], f0, 0); SCHED; LW(f0, q0, 0); SCHED; MS(vn[1], f1, 1);
                SCHED; LW(f1, q0, 1); SCHED;
            }
#pragma unroll
            for (int j = 0; j < 16; ++j) { o[0][j] = 0.f; o[1][j] = 0.f; }
            MS(o[0], f0, 0); SCHED; LW(f0, q1, 0); SCHED; MS(o[0], f1, 1); SCHED; LW(f1, q1, 1); SCHED;
            MS(o[1], f0, 0); SCHED;
            f0[0] = loadA(Al + r * 68 + 4 * hh); f0[1] = loadA(Al + r * 68 + 16 + 4 * hh); f0[2] = loadA(Al + (32 + r) * 68 + 4 * hh);
            SCHED; MS(o[1], f1, 1);
            bf16x8 vb[2][2];
            if (KIND == 0) {
#pragma unroll
                for (int mt = 0; mt < 2; ++mt) { vb[mt][0] = pack8(vn[mt], 0); vb[mt][1] = pack8(vn[mt], 1); }
            } else {
#pragma unroll
                for (int mt = 0; mt < 2; ++mt) { vb[mt][0] = loadA(up + 32 * mt); vb[mt][1] = loadA(up + 32 * mt + 16); }
            }
            SCHED;
            f1[0] = loadA(Al + (32 + r) * 68 + 16 + 4 * hh); f1[1] = loadA(Al + (32 + r) * 68 + 32 + 4 * hh); f1[2] = loadA(Al + (32 + r) * 68 + 48 + 4 * hh);
            SCHED;
            o[0] = MFMA32(f0[0], vb[0][0], o[0]); o[1] = MFMA32(f0[2], vb[0][0], o[1]); o[0] = MFMA32(f0[1], vb[0][1], o[0]);
            SCHED; LK(f0, 0); SCHED;
            o[1] = MFMA32(f1[0], vb[0][1], o[1]); o[1] = MFMA32(f1[1], vb[1][0], o[1]); o[1] = MFMA32(f1[2], vb[1][1], o[1]);
            SCHED;
            SU(0, f0); SCHED; LK(f1, 1); SCHED; SU(1, f1); SCHED; LK(f0, 2); SCHED; SU(2, f0); SCHED; LK(f1, 3); SCHED; SU(3, f1);
            float* ob = obuf + (n & 1) * 64 * 132 + dv0 + r;
#pragma unroll
            for (int mt = 0; mt < 2; ++mt)
#pragma unroll
                for (int j = 0; j < 16; ++j) ob[(32 * mt + crow(j, hh)) * 132] = o[mt][j];
#ifdef PROBE_SEL
            asm volatile("s_waitcnt lgkmcnt(0)" ::: "memory");
            const unsigned long long pt1 = __builtin_amdgcn_s_memrealtime();
            LBAR();
            const unsigned long long pt2 = __builtin_amdgcn_s_memrealtime();
            scan_epilogue(sp, lds, n, tid, zr);
            LBAR();
            const unsigned long long pt3 = __builtin_amdgcn_s_memrealtime();
            tacc += (PROBE_SEL == 1) ? (pt1 - pt0) : (PROBE_SEL == 2) ? (pt2 - pt1) : (pt3 - pt2);
#else
            LBAR();
            scan_epilogue(sp, lds, n, tid, zr);
            LBAR();
#endif
        }
#ifdef PROBE_SEL
        if (KIND == PROBE_KIND && blockIdx.x == 0 && wv == 0) {
            const unsigned long long ps = __builtin_amdgcn_s_memrealtime();
            while (__builtin_amdgcn_s_memrealtime() - ps < tacc * PROBE_MUL) __builtin_amdgcn_s_sleep(8);
        }
#endif
    } else {
        u32x4 rwB[4], rqB[4], raB[2], rkB[4], ruB[4]; f32x4 rdB = {0.f, 0.f, 0.f, 0.f};
#define LBODY(n_, XW, XQ, XA, XK, XU, XD, YW, YQ, YA, YK, YU, YD, ZC, ZN) do { \
            if ((n_) + 2 < NCH) scan_issue<KIND>(sp, (n_) + 2, lt, YW, YQ, YA, YK, YU, YD); \
            LBAR(); \
            if ((n_) + 1 < NCH) scan_fill<KIND>(lds, lt, XW, XQ, XA, XK, XU, XD); \
            LBAR(); } while (0)
#pragma unroll 1
        for (int n = 1; n < NCH; n += 2) {
            LBODY(n, rwA, rqA, raA, rkA, ruA, rdA, rwB, rqB, raB, rkB, ruB, rdB, zrB, zrA);
            if (n + 1 < NCH) LBODY(n + 1, rwB, rqB, raB, rkB, ruB, rdB, rwA, rqA, raA, rkA, ruA, rdA, zrA, zrB);
        }
#undef LBODY
    }
#undef SCHED
#undef LBAR
#undef LW
#undef MS
#undef LK
#undef SU
    __syncthreads();
}

DI void sb_item(const P& p, int item, bf16_t* vT  , int lane) {
    const int r = lane & 31, hh = lane >> 5;
    const int bh = item / 129, qt = 131 - (item - bh * 129), b = bh >> 3, h = bh & 7;
    const bf16_t* base = (const bf16_t*)(p.ws + WS_R1) + (size_t)b * TT * N0;
    const int q0 = 32 * qt, qpos = q0 + r;
    bf16x8 qf[4];
#pragma unroll
    for (int s = 0; s < 4; ++s) qf[s] = *(const bf16x8*)(base + (size_t)(q0 + r) * N0 + 2048 + h * 64 + 16 * s + 8 * hh);
    f32x16 o[2];
#pragma unroll
    for (int j = 0; j < 16; ++j) { o[0][j] = 0.f; o[1][j] = 0.f; }
    float R = 0.f;
    bf16x8 kf[4]; u32x4 v8[4];
#pragma unroll
    for (int s = 0; s < 4; ++s) kf[s] = *(const bf16x8*)(base + (size_t)(32 * qt + r) * N0 + 2560 + h * 64 + 16 * s + 8 * hh);
#pragma unroll
    for (int i = 0; i < 4; ++i) { const int c = i * 64 + lane; v8[i] = *(const u32x4*)(base + (size_t)(32 * qt + (c >> 3)) * N0 + 3072 + h * 64 + (c & 7) * 8); }
#pragma unroll 1
    for (int kt = qt; kt >= 3; --kt) {
        const int k0 = 32 * kt;
        const int kn = kt > 3 ? 32 * (kt - 1) : k0;
        bf16x8 kfn[4]; u32x4 v8n[4];
#pragma unroll
        for (int s = 0; s < 4; ++s) kfn[s] = *(const bf16x8*)(base + (size_t)(kn + r) * N0 + 2560 + h * 64 + 16 * s + 8 * hh);
#pragma unroll
        for (int i = 0; i < 4; ++i) { const int c = i * 64 + lane; v8n[i] = *(const u32x4*)(base + (size_t)(kn + (c >> 3)) * N0 + 3072 + h * 64 + (c & 7) * 8); }
        f32x16 z;
#pragma unroll
        for (int j = 0; j < 16; ++j) z[j] = 0.f;
#pragma unroll
        for (int s = 0; s < 4; ++s) z = MFMA32(kf[s], qf[s], z);
#pragma unroll
        for (int i = 0; i < 4; ++i) {
            const int c = i * 64 + lane, key = c >> 3, d0 = (c & 7) * 8;
#pragma unroll
            for (int e = 0; e < 8; ++e) vT[(d0 + e) * 36 + key] = (unsigned short)((e & 1) ? (v8[i][e >> 1] >> 16) : (v8[i][e >> 1] & 0xffffu));
        }
#pragma unroll
        for (int s = 0; s < 4; ++s) { kf[s] = kfn[s]; v8[s] = v8n[s]; }
        float l[16], ls[16], suf[16]; bool al[16];
#pragma unroll
        for (int j = 0; j < 16; ++j) {
            const int key = k0 + crow(j, hh);
            const float zz = z[j] * 0.125f;
            al[j] = (key < qpos) && (key >= PADF);
            const float sp = softplusf_(zz);
            l[j] = al[j] ? -sp : 0.f; ls[j] = zz - sp;
        }
        float G[4], Pg[4], offs[4];
#pragma unroll
        for (int g = 0; g < 4; ++g) {
            suf[4 * g + 3] = 0.f; suf[4 * g + 2] = l[4 * g + 3]; suf[4 * g + 1] = suf[4 * g + 2] + l[4 * g + 2]; suf[4 * g] = suf[4 * g + 1] + l[4 * g + 1];
            G[g] = suf[4 * g] + l[4 * g];
            Pg[g] = __shfl_xor(G[g], 32);
        }
        float tail = 0.f;
#pragma unroll
        for (int g = 3; g >= 0; --g) { offs[g] = tail + (hh == 0 ? Pg[g] : 0.f); tail += G[g] + Pg[g]; }
        f32x16 pw;
#pragma unroll
        for (int j = 0; j < 16; ++j) pw[j] = al[j] ? __expf(ls[j] + R + offs[j >> 2] + suf[j]) : 0.f;
        R += tail;
        const bf16x8 pb0 = pack8(pw, 0), pb1 = pack8(pw, 1);
#pragma unroll
        for (int mt = 0; mt < 2; ++mt) {
            o[mt] = MFMA32(loadA(vT + (32 * mt + r) * 36 + 4 * hh), pb0, o[mt]);
            o[mt] = MFMA32(loadA(vT + (32 * mt + r) * 36 + 16 + 4 * hh), pb1, o[mt]);
        }
        if (__ballot(R > -105.f) == 0ull) break;
    }
    bf16_t* op = (bf16_t*)(p.ws + WS_MIX) + ((size_t)b * TT + q0 + r) * DM + 512 + h * 64 + 4 * hh;
#pragma unroll
    for (int mt = 0; mt < 2; ++mt)
#pragma unroll
        for (int g = 0; g < 4; ++g) {
            u32x2 w = {pack2(o[mt][4 * g], o[mt][4 * g + 1]), pack2(o[mt][4 * g + 2], o[mt][4 * g + 3])};
            *(u32x2*)(op + 32 * mt + 8 * g) = w;
        }
}

#define XB_TMO      128
#define XB_XCNT(j)  (256  + 64 * (j))
#define XB_XSUB(j)  (1280 + 64 * (j))
#define XB_XGEN(j)  (2304 + 64 * (j))
#define XB_TOP      3328
#define XB_TOPGEN   3392
#define XCD_BAR_WORDS 3456
#define XB_SPIN_CAP (1u << 18)
#define LAS __attribute__((address_space(3)))

__device__ __forceinline__ unsigned xb_ld(unsigned* p)              { return __hip_atomic_load(p, __ATOMIC_RELAXED, __HIP_MEMORY_SCOPE_AGENT); }
__device__ __forceinline__ unsigned xb_add(unsigned* p, unsigned v) { return __hip_atomic_fetch_add(p, v, __ATOMIC_RELAXED, __HIP_MEMORY_SCOPE_AGENT); }
__device__ __forceinline__ unsigned xb_xcc_id() { return (unsigned)__builtin_amdgcn_s_getreg((3 << 11) | 20) & 0xFu; }
#define XB_SPIN(cond, bar) do { unsigned _sp = 0; while (cond) { __builtin_amdgcn_s_sleep(1); \
    if ((++_sp & 255u) == 0u) { if (xb_ld(&(bar)[XB_TMO])) break; if (_sp > XB_SPIN_CAP) { atomicAdd(&(bar)[XB_TMO], 1u); break; } } } } while (0)

struct XcdBarrier {
    unsigned* bar; unsigned x;
    volatile LAS unsigned* st;
};

__device__ __forceinline__ XcdBarrier xcd_barrier_post(unsigned* bar, volatile LAS unsigned* st) {
    XcdBarrier b; b.bar = bar; b.x = xb_xcc_id(); b.st = st;
    if (threadIdx.x == 0) (void)xb_add(&bar[XB_XCNT(b.x)], 1u);
    return b;
}
__device__ __forceinline__ void xcd_barrier_complete(unsigned* bar, unsigned x, unsigned& nloc, unsigned& nx) {
    const unsigned G = gridDim.x * gridDim.y * gridDim.z;
    unsigned sum, cnt, mine, sp = 0u;
    for (;;) {
        sum = 0u; cnt = 0u; mine = 0u;
#pragma unroll
        for (unsigned j = 0; j < 16; ++j) { const unsigned c = xb_ld(&bar[XB_XCNT(j)]); sum += c; cnt += (c > 0u) ? 1u : 0u; mine = (j == x) ? c : mine; }
        if (sum == G) break;
        __builtin_amdgcn_s_sleep(1);
        if ((++sp & 255u) == 0u) { if (xb_ld(&bar[XB_TMO])) break; if (sp > XB_SPIN_CAP) { atomicAdd(&bar[XB_TMO], 1u); break; } }
    }
    nloc = mine > 0u ? mine : 1u; nx = cnt > 0u ? cnt : 1u;
}

__device__ __forceinline__ void xcd_barrier(const XcdBarrier& b) {
    asm volatile("s_waitcnt vmcnt(0)" ::: "memory");
    __syncthreads();
    if (threadIdx.x == 0) {
        unsigned* bar = b.bar;
        __builtin_amdgcn_s_waitcnt(0);
        unsigned nloc = b.st[0], nx = b.st[1];
        if (nloc == 0u) { xcd_barrier_complete(bar, b.x, nloc, nx); b.st[0] = nloc; b.st[1] = nx; }
        const unsigned old = xb_add(&bar[XB_XSUB(b.x)], 1u);
        const unsigned gen = old / nloc;
        if (old + 1u == (gen + 1u) * nloc) {
            __builtin_amdgcn_fence(__ATOMIC_RELEASE, "agent");
            asm volatile("s_waitcnt vmcnt(0)" ::: "memory");
            const unsigned og = xb_add(&bar[XB_TOP], 1u);
            const unsigned tg = og / nx;
            if (og + 1u == (tg + 1u) * nx) xb_add(&bar[XB_TOPGEN], 1u);
            else XB_SPIN(xb_ld(&bar[XB_TOPGEN]) == tg, bar);
            __builtin_amdgcn_fence(__ATOMIC_ACQUIRE, "agent");
            xb_add(&bar[XB_XGEN(b.x)], 1u);
            asm volatile("s_waitcnt vmcnt(0)" ::: "memory");
        } else {
            XB_SPIN(xb_ld(&bar[XB_XGEN(b.x)]) == gen, bar);
            __builtin_amdgcn_fence(__ATOMIC_ACQUIRE, "agent");
            asm volatile("s_waitcnt vmcnt(0)" ::: "memory");
        }
    }
    __syncthreads();
}


constexpr int NPHASE = 17;
#ifndef KSEL
#define KSEL 0x1ff
#endif
#define KON(k) (((KSEL) >> (k)) & 1)
#ifndef DUP_MASK
#define DUP_MASK 0
#endif
__global__ __launch_bounds__(512) void mega(P p) {
    extern __shared__ __attribute__((aligned(16))) unsigned char shm[];
    cg::grid_group grid = cg::this_grid();
    bf16_t* h16 = (bf16_t*)(p.ws + WS_H16); bf16_t* r1 = (bf16_t*)(p.ws + WS_R1); bf16_t* mix = (bf16_t*)(p.ws + WS_MIX);
    float* side = (float*)(p.ws + WS_SIDE);
    unsigned* ctl = (unsigned*)(p.ws + WS_CTL);
    volatile LAS unsigned* xst = (volatile LAS unsigned*)(shm + LDS_BYTES - 16);
    if (threadIdx.x == 0) { xst[0] = 0u; xst[1] = 0u; }
    __syncthreads();
    XcdBarrier xbar = xcd_barrier_post(ctl, xst);
    int nsync = 0;
#ifdef SYNC_EXTRA
    for (int i = 0; i < SYNC_EXTRA; ++i) xcd_barrier(xbar);
#endif
#pragma unroll 1
    for (int phx = p.ph_lo * 2; phx < p.ph_hi * 2; ++phx) {
        const int ph = phx >> 1, rep = phx & 1;
        if (rep && !((DUP_MASK >> ph) & 1)) continue;
        int kind = 0;
        pg8::Gemm g{}; bf16_t* O = nullptr; int ldc = 0, act = 0; const float* lg = nullptr; const float* lb = nullptr; int fin = 0; bf16_t* Y = nullptr; int sl = 0, sh = 0, nk = 0;
        g.M = MROWS; g.K = 1024; g.xonly = 0; g.lda = 1024; g.ldb = 1024;
        switch (ph) {
            case 0: kind = 4; break;
            case 1: kind = 1; g.A = h16; g.Bt = (const bf16_t*)(p.ws + WS_WAB); g.N = N0; O = r1; ldc = N0; sl = 6; sh = 8; break;
            case 2: kind = 5; break;
            case 3: kind = 6; break;
            case 4: kind = 2; g.A = mix; g.Bt = (const bf16_t*)(p.ws + WS_WABO); g.N = 1024; Y = r1; g.M = TAIL0; nk = 4; break;
            case 5: kind = 3; lg = p.in[12]; lb = p.in[13]; Y = r1; nk = 4; break;
            case 6: kind = 1; g.A = h16; g.Bt = (const bf16_t*)(p.ws + WS_W1); g.N = 4096; O = r1; ldc = LD1; act = 1; break;
            case 7: kind = 2; g.A = r1; g.Bt = (const bf16_t*)(p.ws + WS_W2); g.N = 1024; g.K = 4096; g.lda = LD1; g.ldb = 4096; Y = mix; g.M = TAIL0; nk = 16; break;
            case 8: kind = 3; lg = p.in[16]; lb = p.in[17]; Y = mix; nk = 16; break;
            case 9: kind = 1; g.A = h16; g.Bt = (const bf16_t*)(p.ws + WS_WC); g.N = N1; O = r1; ldc = LD1; sl = 12; sh = 16; break;
            case 10: kind = 7; break;
            case 11: kind = 8; break;
            case 12: kind = 2; g.A = mix; g.Bt = (const bf16_t*)(p.ws + WS_WCO); g.N = 1024; Y = r1; g.M = NB * SEQ; g.xonly = 1; break;
            case 13: kind = 3; lg = p.in[12] + 1024; lb = p.in[13] + 1024; Y = r1; g.xonly = 1; break;
            case 14: kind = 1; g.A = h16; g.Bt = (const bf16_t*)(p.ws + WS_W1) + (size_t)4096 * 1024; g.N = 4096; O = r1; ldc = LD1; act = 1; g.M = NB * SEQ; g.xonly = 1; break;
            case 15: kind = 2; g.A = r1; g.Bt = (const bf16_t*)(p.ws + WS_W2) + (size_t)4096 * 1024; g.N = 1024; g.K = 4096; g.lda = LD1; g.ldb = 4096; Y = mix; g.M = NB * SEQ; g.xonly = 1; break;
            default: kind = 3; lg = p.in[16] + 1024; lb = p.in[17] + 1024; fin = 1; Y = mix; g.xonly = 1; break;
        }
        if (KON(1) && kind == 1) {
            pg8::StaticOrder S; S.init(g.M, g.N, (int)gridDim.x, (int)blockIdx.x);
            EpiStore E{O, ldc, act, g.xonly, sl, sh};
            pg8::gemm_phase<EpiStore, pg8::StaticOrder, false>((PG8_LAS unsigned char*)shm, g, S, E, nullptr);
        } else if (KON(2) && kind == 2) {
            pg8::StaticOrder S; S.init(g.M, g.N, (int)gridDim.x, (int)blockIdx.x);
            EpiResid E{h16, Y, g.xonly};
            pg8::gemm_phase<EpiResid, pg8::StaticOrder, false>((PG8_LAS unsigned char*)shm, g, S, E, nullptr);
            if (nk > 0) {
                pg8::Gemm gt = g; gt.K = 256;
                pg8::TailOrder T; T.npieces = 16 * nk; T.nk = nk; T.pm0 = TAIL0 / 256; T.G = (int)gridDim.x; T.c = (int)blockIdx.x;
                EpiPart EP{p.out, TAIL0};
                pg8::gemm_phase<EpiPart, pg8::TailOrder, false>((PG8_LAS unsigned char*)shm, gt, T, EP, nullptr);
            }
        } else if (KON(3) && kind == 3) {
            ln_phase(p, Y, lg, lb, g.xonly, fin, nk);
        } else if (KON(4) && kind == 4) {
            prep_phase(p, shm, 0, (int)blockIdx.x, (int)gridDim.x);
        } else if (KON(5) && kind == 5) {
            for (int it = blockIdx.x; it < NB * 4 * NCH; it += gridDim.x) gdn_prep_item(p, it, shm);
        } else if (KON(6) && kind == 6) {
#ifdef PROBE2
            const unsigned long long q0 = __builtin_amdgcn_s_memrealtime();
#endif
            for (int ch = blockIdx.x; ch < NB * 4; ch += gridDim.x) scan_chain<0>(p, ch, shm);
#ifdef PROBE2
            const unsigned long long q1 = __builtin_amdgcn_s_memrealtime();
#endif
            const int tid = my_tid();
            bf16_t* vT = (bf16_t*)shm + (tid >> 6) * (64 * 36);
            for (;;) {
                int it = 0;
                if ((tid & 63) == 0) it = (int)atomicAdd(ctl + rep, 1u);
                it = __builtin_amdgcn_readfirstlane(it);
                if (it >= SB_ITEMS) break;
                sb_item(p, it, vT, tid & 63);
            }
            __syncthreads();
            { int bid = blockIdx.x, gsz = gridDim.x; asm volatile("" : "+s"(bid), "+s"(gsz));
              if (rep == 0) { if (gsz > NB * 4) { if (bid >= NB * 4) prep_phase(p, shm, 1, bid - NB * 4, gsz - NB * 4); } else prep_phase(p, shm, 1, bid, gsz); } }
#ifdef PROBE2
            { const unsigned long long q2 = __builtin_amdgcn_s_memrealtime();
              if (rep == 0 && threadIdx.x == 0 && (int)blockIdx.x == ((PROBE2 == 1) ? 0 : 255) && PROBE2 < 3) ctl[96] = (unsigned)((PROBE2 == 1) ? (q1 - q0) : (q2 - q0)); }
#endif
        } else if (KON(7) && kind == 7) {
            { const int tid = my_tid(); HgIn hin;
              { const float* lbr = p.in[9]; float* lbs = (float*)(shm + 36864);
                for (int i = tid; i < 1024; i += 512) lbs[i] = sigmoidf_(lbr[1024 + i] - lbr[i]);
                __syncthreads(); }
              hin.i8a = hin.i8b = hin.q8a = hin.q8b = hin.f8a = hin.f8b = (u32x4){0u, 0u, 0u, 0u};
              int it = blockIdx.x;
              if (it < NB * 8 * NCH) hg_prep_load(p, it, tid, hin);
              for (; it < NB * 8 * NCH; it += gridDim.x) { const int nx = it + (int)gridDim.x; hg_prep_item(p, it, nx < NB * 8 * NCH ? nx : -1, shm, tid, hin); } }
        } else if (KON(8) && kind == 8) {
#if defined(PROBE2) && PROBE2 == 3
            const unsigned long long q0 = __builtin_amdgcn_s_memrealtime();
#endif
            for (int ch = blockIdx.x; ch < NB * 8; ch += gridDim.x) scan_chain<1>(p, ch, shm);
#if defined(PROBE2) && PROBE2 == 3
            if (rep == 0 && threadIdx.x == 0 && blockIdx.x == 0) ctl[96] = (unsigned)(__builtin_amdgcn_s_memrealtime() - q0);
#endif
            { int bid = blockIdx.x, gsz = gridDim.x; asm volatile("" : "+s"(bid), "+s"(gsz));
              if (rep == 0) { if (gsz > NB * 8) { if (bid >= NB * 8) prep_phase(p, shm, 2, bid - NB * 8, gsz - NB * 8); } else prep_phase(p, shm, 2, bid, gsz); } }
        }
        if (!(ph == p.ph_hi - 1 && rep == ((DUP_MASK >> ph) & 1))) { if (nsync == 0) grid.sync(); else xcd_barrier(xbar); ++nsync; }
    }
#ifdef PROBE3
    if (threadIdx.x == 0 && blockIdx.x == 0) {
        const unsigned long long t = (unsigned long long)ctl[96] * 2ull, ps = __builtin_amdgcn_s_memrealtime();
        while (__builtin_amdgcn_s_memrealtime() - ps < t) __builtin_amdgcn_s_sleep(8);
    }
#endif
#ifdef PROBE2
    if (threadIdx.x == 0 && (int)blockIdx.x == ((PROBE2 == 2) ? 255 : 0)) {
        const unsigned long long t = (unsigned long long)ctl[96] * 2ull, ps = __builtin_amdgcn_s_memrealtime();
        while (__builtin_amdgcn_s_memrealtime() - ps < t) __builtin_amdgcn_s_sleep(8);
    }
#endif
}

extern "C" void kernel_launch(void* const* d_in, const int* in_sizes, int n_in, void* d_out, int out_size, void* d_ws, size_t ws_size, hipStream_t stream) {
    static int grid = 0;
    if (grid == 0) {
        if (n_in != 18 || out_size != NB * SEQ * DM || ws_size < WS_END) { fprintf(stderr, "kernel_launch: unexpected shapes (n_in %d out %d ws %zu need %zu)\n", n_in, out_size, ws_size, (size_t)WS_END); grid = -1; return; }
        int dev = 0, cus = 0, per_cu = 0;
        hipGetDevice(&dev);
        hipDeviceGetAttribute(&cus, hipDeviceAttributeMultiprocessorCount, dev);
        if (hipFuncSetAttribute((const void*)mega, hipFuncAttributeMaxDynamicSharedMemorySize, LDS_BYTES) != hipSuccess) { fprintf(stderr, "kernel_launch: hipFuncSetAttribute failed\n"); grid = -1; return; }
        hipOccupancyMaxActiveBlocksPerMultiprocessor(&per_cu, (const void*)mega, 512, LDS_BYTES);
        if (per_cu < 1) { fprintf(stderr, "kernel_launch: occupancy query says %d blocks per CU\n", per_cu); per_cu = 1; }
        (void)hipGetLastError();
        grid = cus;
    }
    if (grid < 0) return;
    hipMemsetAsync((unsigned char*)d_ws + WS_CTL, 0, 16384, stream);
    P p{};
    for (int i = 0; i < 18; ++i) p.in[i] = (const float*)d_in[i];
    p.out = (float*)d_out; p.ws = (unsigned char*)d_ws;
#ifndef MK_MULTI
    p.ph_lo = 0; p.ph_hi = NPHASE;
    void* args[] = {&p};
    hipError_t e = hipLaunchCooperativeKernel((const void*)mega, dim3(grid), dim3(512), args, LDS_BYTES, stream);
    if (e != hipSuccess) fprintf(stderr, "cooperative launch failed: %s (grid %d)\n", hipGetErrorString(e), grid);
#else
    for (int ph = 0; ph < NPHASE; ++ph) { p.ph_lo = ph; p.ph_hi = ph + 1; hipLaunchKernelGGL(mega, dim3(grid), dim3(512), LDS_BYTES, stream, p); }
#endif
}
```
